# Optimizing an MI355X kernel written in HIP

```python
import math
import jax
import jax.numpy as jnp
from jax import lax
import numpy as np

D_MODEL = 2048
BATCH = 8
SEQ = 4096
DEPTH = 4

CHUNK = 64
N_EVEN = (DEPTH + 1) // 2
N_ODD = DEPTH // 2
D_FF = ((8 * D_MODEL // 3 + 255) // 256) * 256
RMS_EPS = 1e-6
LN_EPS = 1e-5
NEG_INF = -1e30

CONV_W = 3
A_WIDTH = D_MODEL // 2
POOL_WINDOWS = (2, 4, 8, 16)
N_POOL = len(POOL_WINDOWS)
B_WIDTH = D_MODEL // 2
B_GROUP = B_WIDTH // N_POOL
AB_IN = 3 * A_WIDTH + B_WIDTH

C_HEADS = D_MODEL // 256
C_HEAD_DIM = 128
C_WIDTH = C_HEADS * C_HEAD_DIM
IDX_HEADS = 16
IDX_DIM = 64
IDX_W_SCALE = IDX_HEADS ** -0.5
TOPK_MAX = 256
Q_BLOCK = 128
NUM_BUCKETS = 32
MAX_DISTANCE = 128

R_HEADS = D_MODEL // 256
R_QK_DIM = 64
R_V_DIM = 128
R_WIDTH = R_HEADS * R_V_DIM
ROPE_BASE = 10000.0

CD_SIZES = (C_WIDTH, C_WIDTH, C_WIDTH,
            IDX_HEADS * IDX_DIM, IDX_DIM, IDX_HEADS,
            R_HEADS * R_QK_DIM, R_HEADS * R_QK_DIM,
            R_WIDTH, R_WIDTH)
CD_IN = sum(CD_SIZES)

kernel_name = 'hybrid_chunk_causal_conv_pool_dsa_retention'


def _split(a, sizes):
    outs, off = [], 0
    for s in sizes:
        outs.append(a[..., off:off + s])
        off += s
    return outs


def rmsnorm(x, g):
    xf = x.astype(jnp.float32)
    y = xf * lax.rsqrt(jnp.mean(xf * xf, axis=-1, keepdims=True) + RMS_EPS)
    return (y * g.astype(jnp.float32)).astype(x.dtype)


def swiglu_ffn(h, w_gate_up, w_down):
    gu = h @ w_gate_up
    gate, up = gu[..., :D_FF], gu[..., D_FF:]
    return (jax.nn.silu(gate) * up) @ w_down


def short_gated_conv(a_in, conv_w):
    b, c, h = _split(a_in, (A_WIDTH, A_WIDTH, A_WIDTH))
    u = c * h
    T = u.shape[1]
    up = jnp.pad(u, ((0, 0), (CONV_W - 1, 0), (0, 0)))
    y = sum(conv_w[j] * up[:, j:j + T] for j in range(CONV_W))
    return b * y


def multiscale_pool(b_in, pool_w, pool_scale):
    Bsz, T, _ = b_in.shape
    ug = b_in.reshape(Bsz, T, N_POOL, B_GROUP).astype(jnp.float32)
    cs = jnp.pad(jnp.cumsum(ug, axis=1), ((0, 0), (1, 0), (0, 0), (0, 0)))
    t = jnp.arange(T)
    win = jnp.array(POOL_WINDOWS, dtype=jnp.int32)
    start = jnp.maximum(t[:, None] + 1 - win[None, :], 0)
    lower = cs[:, start, jnp.arange(N_POOL)[None, :], :]
    count = (t[:, None] + 1 - start).astype(jnp.float32)
    pooled = (cs[:, 1:] - lower) / count[None, :, :, None] - ug
    mixed = jnp.einsum('btgc,gcd->btgd', pooled.astype(b_in.dtype), pool_w)
    return mixed.reshape(Bsz, T, B_WIDTH) * pool_scale


def t5_bucket(rel):
    nb = NUM_BUCKETS // 2
    max_exact = nb // 2
    ret = jnp.where(rel > 0, nb, 0)
    n = jnp.abs(rel)
    large = max_exact + (jnp.log(jnp.maximum(n, 1).astype(jnp.float32) / max_exact)
                         / math.log(MAX_DISTANCE / max_exact) * (nb - max_exact)).astype(jnp.int32)
    large = jnp.minimum(large, nb - 1)
    return ret + jnp.where(n < max_exact, n, large)


def dsa_attention(q, k, v, q_idx, k_idx, w_idx, rel_bias_table):
    Bsz, T, H, Dh = q.shape
    topk = min(TOPK_MAX, T // 4)
    n_blocks = T // Q_BLOCK
    key_pos = jnp.arange(T)
    k_idx32 = k_idx.astype(jnp.float32)
    table = rel_bias_table.astype(jnp.float32)
    gather = jax.vmap(lambda a, i: a[i])

    def one_block(blk):
        t0 = blk * Q_BLOCK
        qb = lax.dynamic_slice_in_dim(q, t0, Q_BLOCK, axis=1)
        qib = lax.dynamic_slice_in_dim(q_idx, t0, Q_BLOCK, axis=1).astype(jnp.float32)
        wib = lax.dynamic_slice_in_dim(w_idx, t0, Q_BLOCK, axis=1).astype(jnp.float32) * IDX_W_SCALE
        q_pos = t0 + jnp.arange(Q_BLOCK)
        vis_end = (q_pos // CHUNK + 1) * CHUNK
        dots = jnp.einsum('bqhd,bsd->bqhs', qib, k_idx32) * (IDX_DIM ** -0.5)
        score = jnp.einsum('bqh,bqhs->bqs', wib, jax.nn.relu(dots))
        admissible = key_pos[None, :] < vis_end[:, None]
        score = jnp.where(admissible[None], score, NEG_INF)
        _, sel = lax.top_k(score, topk)
        valid = sel < vis_end[None, :, None]
        kg = gather(k, sel)
        vg = gather(v, sel)
        logits = jnp.einsum('bqhd,bqkhd->bqhk', qb, kg).astype(jnp.float32) * (Dh ** -0.5)
        bias = table[t5_bucket(sel - q_pos[None, :, None])]
        logits = logits + jnp.moveaxis(bias, -1, 2)
        logits = jnp.where(valid[:, :, None, :], logits, NEG_INF)
        p = jax.nn.softmax(logits, axis=-1).astype(v.dtype)
        return jnp.einsum('bqhk,bqkhd->bqhd', p, vg)

    out = lax.map(one_block, jnp.arange(n_blocks))
    return jnp.moveaxis(out, 0, 1).reshape(Bsz, T, H * Dh)


def rope(x, pos):
    half = x.shape[-1] // 2
    freqs = ROPE_BASE ** (-jnp.arange(half, dtype=jnp.float32) / half)
    ang = pos.astype(jnp.float32)[:, None] * freqs[None, :]
    cos = jnp.cos(ang)[None, :, None, :]
    sin = jnp.sin(ang)[None, :, None, :]
    x1, x2 = x[..., :half], x[..., half:]
    return jnp.concatenate([x1 * cos - x2 * sin, x1 * sin + x2 * cos], axis=-1)


def retention(q, k, v, g, ret_gain):
    Bsz, T, H, dk = q.shape
    dv = v.shape[-1]
    nc = T // CHUNK
    pos = jnp.arange(T)
    qf = rope(q.astype(jnp.float32), pos)
    kf = rope(k.astype(jnp.float32), pos) * (dk ** -0.5)
    vf = v.astype(jnp.float32)
    log_g = jnp.log(1.0 - 2.0 ** (-5.0 - jnp.arange(H, dtype=jnp.float32)))
    qc = qf.reshape(Bsz, nc, CHUNK, H, dk)
    kc = kf.reshape(Bsz, nc, CHUNK, H, dk)
    vc = vf.reshape(Bsz, nc, CHUNK, H, dv)
    i = jnp.arange(CHUNK)
    intra = jnp.exp(jnp.abs(i[:, None] - i[None, :]).astype(jnp.float32)[None] * log_g[:, None, None])
    a = jnp.einsum('bnihd,bnjhd->bnhij', qc, kc) * intra[None, None]
    o_intra = jnp.einsum('bnhij,bnjhe->bnihe', a, vc)
    k_dec = jnp.exp((CHUNK - 1 - i).astype(jnp.float32)[:, None] * log_g[None, :])
    kv = jnp.einsum('bnjhd,jh,bnjhe->nbhde', kc, k_dec, vc)
    chunk_dec = jnp.exp(CHUNK * log_g)[None, :, None, None]

    def step(state, kv_n):
        return state * chunk_dec + kv_n, state

    _, prev = lax.scan(step, jnp.zeros((Bsz, H, dk, dv), jnp.float32), kv)
    q_dec = jnp.exp((i + 1).astype(jnp.float32)[:, None] * log_g[None, :])
    o_inter = jnp.einsum('bnihd,ih,nbhde->bnihe', qc, q_dec, prev)
    o = (o_intra + o_inter).reshape(Bsz, T, H, dv)
    mu = jnp.mean(o, axis=-1, keepdims=True)
    var = jnp.mean(jnp.square(o - mu), axis=-1, keepdims=True)
    o = ((o - mu) * lax.rsqrt(var + LN_EPS)).reshape(Bsz, T, H * dv) * ret_gain.astype(jnp.float32)
    return (jax.nn.silu(g.astype(jnp.float32)) * o).astype(g.dtype)


def conv_pool_mixer(u, w_in, conv_w, pool_w, pool_scale, w_out):
    proj = u @ w_in
    ya = short_gated_conv(proj[..., :3 * A_WIDTH], conv_w)
    yb = multiscale_pool(proj[..., 3 * A_WIDTH:], pool_w, pool_scale)
    return jnp.concatenate([ya, yb], axis=-1) @ w_out


def sparse_retention_mixer(u, w_in, ret_gain, rel_bias_table, w_out):
    Bsz, T, _ = u.shape
    proj = u @ w_in
    cq, ck, cv, iq, ik, iw, rq, rk, rv, rg = _split(proj, CD_SIZES)
    heads = lambda a, h: a.reshape(Bsz, T, h, -1)
    yc = dsa_attention(heads(cq, C_HEADS), heads(ck, C_HEADS), heads(cv, C_HEADS),
                       heads(iq, IDX_HEADS), ik, iw, rel_bias_table)
    yd = retention(heads(rq, R_HEADS), heads(rk, R_HEADS), heads(rv, R_HEADS), rg, ret_gain)
    return jnp.concatenate([yc, yd], axis=-1) @ w_out


def setup_inputs(seed: int = 0) -> dict:
    key = jax.random.key(seed)
    ks = jax.random.split(key, 16)
    f32 = jnp.float32
    nrm = lambda k, shape, scale: jax.random.normal(k, shape, f32) * scale
    return {
        'x': nrm(ks[0], (BATCH, SEQ, D_MODEL), 1.0),
        'norm_gains': 1.0 + nrm(ks[1], (DEPTH, 3, D_MODEL), 0.05),
        'ffn_w_gate_up': nrm(ks[2], (DEPTH, 2, D_MODEL, 2 * D_FF), D_MODEL ** -0.5),
        'ffn_w_down': nrm(ks[3], (DEPTH, 2, D_FF, D_MODEL), D_FF ** -0.5),
        'ab_w_in': nrm(ks[4], (N_EVEN, D_MODEL, AB_IN), D_MODEL ** -0.5),
        'ab_conv_w': nrm(ks[5], (N_EVEN, CONV_W, A_WIDTH), CONV_W ** -0.5),
        'ab_pool_w': nrm(ks[6], (N_EVEN, N_POOL, B_GROUP, B_GROUP), B_GROUP ** -0.5),
        'ab_pool_scale': 1.0 + nrm(ks[7], (N_EVEN, B_WIDTH), 0.1),
        'ab_w_out': nrm(ks[8], (N_EVEN, A_WIDTH + B_WIDTH, D_MODEL), (A_WIDTH + B_WIDTH) ** -0.5),
        'cd_w_in': nrm(ks[9], (N_ODD, D_MODEL, CD_IN), D_MODEL ** -0.5),
        'ret_norm_gain': 1.0 + nrm(ks[10], (N_ODD, R_WIDTH), 0.05),
        'cd_w_out': nrm(ks[11], (N_ODD, C_WIDTH + R_WIDTH, D_MODEL), (C_WIDTH + R_WIDTH) ** -0.5),
        'rel_bias_table': nrm(ks[12], (NUM_BUCKETS, C_HEADS), 0.5),
        'final_norm': 1.0 + nrm(ks[13], (D_MODEL,), 0.05),
    }


def reference(x, norm_gains, ffn_w_gate_up, ffn_w_down, ab_w_in, ab_conv_w, ab_pool_w,
              ab_pool_scale, ab_w_out, cd_w_in, ret_norm_gain, cd_w_out, rel_bias_table,
              final_norm):
    h = x
    for layer in range(DEPTH):
        j = layer // 2
        h = h + 0.5 * swiglu_ffn(rmsnorm(h, norm_gains[layer, 0]),
                                 ffn_w_gate_up[layer, 0], ffn_w_down[layer, 0])
        u = rmsnorm(h, norm_gains[layer, 1])
        if layer % 2 == 0:
            mix = conv_pool_mixer(u, ab_w_in[j], ab_conv_w[j], ab_pool_w[j],
                                  ab_pool_scale[j], ab_w_out[j])
        else:
            mix = sparse_retention_mixer(u, cd_w_in[j], ret_norm_gain[j],
                                         rel_bias_table, cd_w_out[j])
        h = h + mix
        h = h + 0.5 * swiglu_ffn(rmsnorm(h, norm_gains[layer, 2]),
                                 ffn_w_gate_up[layer, 1], ffn_w_down[layer, 1])
    return rmsnorm(h, final_norm)
```

```cpp
#include <hip/hip_runtime.h>
#include <cstdio>
#include <cstdint>

#ifndef MK_PHMASK
#define MK_PHMASK 0xffffffffu
#endif
#define EN(k) ((MK_PHMASK >> (k)) & 1u)
#ifndef MK_DUP2MASK
#define MK_DUP2MASK 0u
#endif
#define REP2(k) for (int r2_ = 0; r2_ < (((MK_DUP2MASK >> (k)) & 1u) ? 2 : 1); ++r2_)
#ifndef MK_XBAR
#define MK_XBAR 0
#endif
#ifndef MK_DUPMASK
#define MK_DUPMASK 0u
#endif
#ifndef MK_ONE_LAUNCH
#define MK_ONE_LAUNCH 1
#endif

#define DI __device__ __forceinline__
#define LAS __attribute__((address_space(3)))
typedef unsigned short bf16_t;
typedef short bf16x8 __attribute__((ext_vector_type(8)));
typedef short s16x4 __attribute__((ext_vector_type(4)));
typedef float f32x2 __attribute__((ext_vector_type(2)));
typedef float f32x4 __attribute__((ext_vector_type(4)));
typedef float f32x16 __attribute__((ext_vector_type(16)));
typedef unsigned u32x2 __attribute__((ext_vector_type(2)));
typedef unsigned u32x4 __attribute__((ext_vector_type(4)));
typedef __bf16 nbf2 __attribute__((ext_vector_type(2)));

#define GAS __attribute__((address_space(1)))
template <class T> DI T* as_global(T* p) { return (T*)(GAS T*)p; }
DI int opaque(int x) { asm volatile("" : "+v"(x)); return x; }
DI unsigned pk2(float lo, float hi) { nbf2 v = {(__bf16)lo, (__bf16)hi}; return __builtin_bit_cast(unsigned, v); }
DI float bflo(unsigned w) { return __uint_as_float(w << 16); }
DI float bfhi(unsigned w) { return __uint_as_float(w & 0xffff0000u); }
DI float bf1(bf16_t b) { return __uint_as_float(((unsigned)b) << 16); }
DI float fast_exp2(float x) { return __builtin_amdgcn_exp2f(x); }
DI float silu_f(float x) { return x * __builtin_amdgcn_rcpf(1.0f + fast_exp2(-1.4426950408889634f * x)); }

constexpr int BATCH = 8, T = 4096, D = 2048, M = BATCH * T, FF = 5632, FF2 = 2 * FF, DEPTH = 4;
constexpr int ABIN = 4096, CDIN = 7248, LDP = 7424;
constexpr int CQ = 0, CK = 1024, CV = 2048, IQ = 3072, RQ = 4096, RK = 4608, RV = 5120, RG = 6144, IK = 7168, IW = 7232;
constexpr int NWAVES = 8, NTHREADS = 512;

namespace pg8 {
constexpr int BM = 256, BK = 64, HALF = 128, HTB = HALF * BK * 2, STAGE_BYTES = 8 * HTB, NXCD = 8, WGM = 8;
__host__ __device__ __forceinline__ int lds_byte(int r, int c) { const int st = (r >> 4) * 2 + (c >> 5), rr = r & 15, cc = c & 31, ob = rr * 64 + cc * 2; return st * 1024 + (ob ^ (((ob >> 9) & 1) << 5)); }
__host__ __device__ __forceinline__ void stage_rc(int b, int& R, int& C) { const int st = b / 1024, sb = b % 1024, swz = sb ^ (((sb >> 9) & 1) << 5); R = (st >> 1) * 16 + swz / 64; C = (st & 1) * 32 + (swz % 64) / 2; }
__host__ __device__ __forceinline__ int perm32(int rho) { const int n = rho >> 4, i = rho & 15; return 8 * (i >> 2) + 4 * n + (i & 3); }
struct Unit { int pm, pn; };
struct Gemm { const bf16_t* A; const bf16_t* Bt; int M, N, K; };
struct StaticOrder {
    int nM, nN, nwg, G, c, wgm, rev;
    __host__ __device__ void init(int M_, int N_, int G_, int c_, int wgm_ = WGM, int rev_ = 0) { nM = M_ / BM; nN = N_ / BM; nwg = nM * nN; G = G_; c = c_; wgm = wgm_; rev = rev_; }
    __host__ __device__ bool next(int i, Unit& u) const {
        const long L = (long)i * G + c; if (L >= nwg) return false;
        int wgid = rev ? (nwg - 1 - (int)L) : (int)L; { const int q = nwg / NXCD, r = nwg % NXCD, xcd = wgid % NXCD, off = wgid / NXCD; wgid = (xcd < r ? xcd * (q + 1) : r * (q + 1) + (xcd - r) * q) + off; }
        const int nig = wgm * nN, gid = wgid / nig, fm = gid * wgm, gsz = (nM - fm) < wgm ? (nM - fm) : wgm;
        u.pm = fm + ((wgid % nig) % gsz); u.pn = (wgid % nig) / gsz; return true;
    }
    __device__ __forceinline__ void a_ready(const Unit&) const {}
    __device__ __forceinline__ void done(const Unit&) const {}
};
struct EpiStoreBf16 {
    static constexpr bool PERM = true, AFTER_DRAIN = false;
    bf16_t* O; int ldc; bf16_t* O2; int pn2; const float* rstd;
    struct Pre { float p0, p1; };
    __device__ __forceinline__ void prefetch(Pre& p, const Unit& u, int wr, int lane) const {
        const float* r = rstd + u.pm * BM + wr * 64 + lane; p.p0 = r[0]; p.p1 = r[HALF]; }
    __device__ __forceinline__ float rs_of(const Pre& p, int ai, int m, int fr) const {
        return __int_as_float(__builtin_amdgcn_ds_bpermute((16 * m + fr) << 2, __float_as_int(ai ? p.p1 : p.p0))); }
    __device__ __forceinline__ void operator()(const f32x4 (&acc)[2][2][4][2], const Unit& u, int wr, int wc, int fr, int fq, const Pre& pre) const {
        const bool alt = (u.pn == pn2);
        const int row0 = u.pm * BM + wr * 64 + fr, col0 = (alt ? 0 : u.pn * BM) + wc * 32 + 8 * fq;
        bf16_t* const Ob = alt ? O2 : O; const int ld = alt ? 256 : ldc;
        float rsv[8];
#pragma unroll
        for (int k = 0; k < 8; ++k) rsv[k] = rs_of(pre, k >> 2, k & 3, fr);
#pragma unroll
        for (int ai = 0; ai < 2; ++ai)
#pragma unroll
            for (int m = 0; m < 4; ++m) { const int row = row0 + ai * HALF + m * 16; const float rs = rsv[ai * 4 + m]; bf16_t* rowp = Ob + (size_t)row * ld + col0;
#pragma unroll
                for (int bj = 0; bj < 2; ++bj) { const f32x4 v0 = acc[ai][bj][m][0] * rs, v1 = acc[ai][bj][m][1] * rs;
                    u32x4 w; w.x = pk2(v0[0], v0[1]); w.y = pk2(v0[2], v0[3]); w.z = pk2(v1[0], v1[1]); w.w = pk2(v1[2], v1[3]);
                    *(u32x4*)(rowp + bj * HALF) = w; } }
    }
};
__device__ __forceinline__ void swiglu2(float& p0, float& p1, float g0, float g1, float u0, float u1, float k1, float irs2) {
    float t0, t1;
    asm("v_mul_f32 %2, %4, %8\n\tv_mul_f32 %3, %5, %8\n\tv_exp_f32 %2, %2\n\tv_exp_f32 %3, %3\n\tv_mul_f32 %0, %4, %6\n\tv_mul_f32 %1, %5, %7\n\t"
        "v_fma_f32 %2, %2, %9, %9\n\tv_fma_f32 %3, %3, %9, %9\n\tv_rcp_f32 %2, %2\n\tv_rcp_f32 %3, %3\n\ts_nop 0\n\tv_mul_f32 %0, %0, %2\n\tv_mul_f32 %1, %1, %3"
        : "=&v"(p0), "=&v"(p1), "=&v"(t0), "=&v"(t1) : "v"(g0), "v"(g1), "v"(u0), "v"(u1), "v"(k1), "v"(irs2));
}
struct EpiSwiglu {
    static constexpr bool PERM = true, AFTER_DRAIN = false;
    bf16_t* O; int ldc; const float* rstd;
    struct Pre { float p0, p1; };
    __device__ __forceinline__ void prefetch(Pre& p, const Unit& u, int wr, int lane) const {
        const float* r = rstd + u.pm * BM + wr * 64 + lane; p.p0 = r[0]; p.p1 = r[HALF]; }
    __device__ __forceinline__ float rs_of(const Pre& p, int ai, int m, int fr) const {
        return __int_as_float(__builtin_amdgcn_ds_bpermute((16 * m + fr) << 2, __float_as_int(ai ? p.p1 : p.p0))); }
    __device__ __forceinline__ void operator()(const f32x4 (&acc)[2][2][4][2], const Unit& u, int wr, int wc, int fr, int fq, const Pre& pre) const {
        const int row0 = u.pm * BM + wr * 64 + fr, col0 = u.pn * HALF + wc * 32 + 8 * fq;
        float rsv[8];
#pragma unroll
        for (int k = 0; k < 8; ++k) rsv[k] = rs_of(pre, k >> 2, k & 3, fr);
#pragma unroll
        for (int ai = 0; ai < 2; ++ai)
#pragma unroll
            for (int m = 0; m < 4; ++m) { const int row = row0 + ai * HALF + m * 16; const float rs = rsv[ai * 4 + m]; bf16_t* rowp = O + (size_t)row * ldc + col0;
                const float k1 = -1.4426950408889634f * rs, irs2 = __builtin_amdgcn_rcpf(rs * rs);
                const f32x4 g0 = acc[ai][0][m][0], g1 = acc[ai][0][m][1], u0 = acc[ai][1][m][0], u1 = acc[ai][1][m][1];
                float o[8];
                swiglu2(o[0], o[1], g0[0], g0[1], u0[0], u0[1], k1, irs2); swiglu2(o[2], o[3], g0[2], g0[3], u0[2], u0[3], k1, irs2);
                swiglu2(o[4], o[5], g1[0], g1[1], u1[0], u1[1], k1, irs2); swiglu2(o[6], o[7], g1[2], g1[3], u1[2], u1[3], k1, irs2);
                u32x4 w; w.x = pk2(o[0], o[1]); w.y = pk2(o[2], o[3]); w.z = pk2(o[4], o[5]); w.w = pk2(o[6], o[7]);
                *(u32x4*)rowp = w; }
    }
};
struct EpiResid {
    static constexpr bool PERM = true, AFTER_DRAIN = false;
    bf16_t* HBp; bf16_t* out; int ldc; float* ssq;
    struct Pre { };
    __device__ __forceinline__ void prefetch(Pre&, const Unit&, int, int) const {}
    __device__ __forceinline__ void operator()(const f32x4 (&acc)[2][2][4][2], const Unit& u, int wr, int wc, int fr, int fq, const Pre&) const {
        const int row0 = u.pm * BM + wr * 64 + fr, col0 = u.pn * BM + wc * 32 + 8 * fq;
        const int lane = fr + 16 * fq;
        u32x4 b[2][4][2];
#pragma unroll
        for (int ai = 0; ai < 2; ++ai)
#pragma unroll
            for (int m = 0; m < 4; ++m)
#pragma unroll
                for (int bj = 0; bj < 2; ++bj) b[ai][m][bj] = *(const u32x4*)(HBp + (size_t)(row0 + ai * HALF + m * 16) * ldc + col0 + bj * HALF);
#pragma unroll
        for (int ai = 0; ai < 2; ++ai) {
#pragma unroll
            for (int m = 0; m < 4; ++m) { const int row = row0 + ai * HALF + m * 16; float sq = 0.f;
#pragma unroll
                for (int bj = 0; bj < 2; ++bj) { const u32x4 w = b[ai][m][bj]; const f32x4 a0 = acc[ai][bj][m][0], a1 = acc[ai][bj][m][1];
                    const float h0 = bflo(w.x) + a0[0], h1 = bfhi(w.x) + a0[1], h2 = bflo(w.y) + a0[2], h3 = bfhi(w.y) + a0[3];
                    const float h4 = bflo(w.z) + a1[0], h5 = bfhi(w.z) + a1[1], h6 = bflo(w.w) + a1[2], h7 = bfhi(w.w) + a1[3];
                    sq += ((h0 * h0 + h1 * h1) + (h2 * h2 + h3 * h3)) + ((h4 * h4 + h5 * h5) + (h6 * h6 + h7 * h7));
                    u32x4 o; o.x = pk2(h0, h1); o.y = pk2(h2, h3); o.z = pk2(h4, h5); o.w = pk2(h6, h7);
                    *(u32x4*)(out + (size_t)row * ldc + col0 + bj * HALF) = o; }
                sq += __int_as_float(__builtin_amdgcn_ds_bpermute((lane ^ 16) << 2, __float_as_int(sq)));
                sq += __int_as_float(__builtin_amdgcn_ds_bpermute((lane ^ 32) << 2, __float_as_int(sq)));
                if (fq == 0) ssq[(size_t)row * 32 + u.pn * 4 + wc] = sq; }
            asm volatile("" ::: "memory"); }
    }
};

template <class Epi, class Sched, bool ALIGN_EPI = false, bool SP2 = false>
__device__ __forceinline__ void gemm_phase(LAS unsigned char* lds, const Gemm g, const Sched& S, const Epi& E) {
    const int tid = opaque(threadIdx.x), wid = __builtin_amdgcn_readfirstlane(tid >> 6), lane = tid & 63, wr = wid >> 2, wc = wid & 3, fr = lane & 15, fq = lane >> 4;
    const int K = g.K, nt = K / BK;
    unsigned voffA[2], voffB[2];
#pragma unroll
    for (int i = 0; i < 2; ++i) { int R, C; stage_rc(tid * 16 + i * 8192, R, C); const int Rb = Epi::PERM ? ((R & ~31) + perm32(R & 31)) : R;
        voffA[i] = (unsigned)(R * K + C) * 2u; voffB[i] = (unsigned)(Rb * K + C) * 2u; }
    const size_t kstep = (size_t)(BK * 2);
    const size_t hstep = (size_t)HALF * K * 2;
    const size_t tstep = 2 * hstep;
    const unsigned ldsw = (unsigned)wid * 1024u, ldsb = __builtin_amdgcn_readfirstlane((unsigned)(uintptr_t)lds);
    const int aoff = lds_byte(wr * 64 + fr, fq * 8), boff = lds_byte(wc * 32 + fr, fq * 8);
#define PG8_SA(b, h) (((b) * 2 + (h)) * HTB)
#define PG8_SB(b, h) ((4 + (b) * 2 + (h)) * HTB)
#define PG8_STAGE(bufoff, gbase, voff) do { const unsigned l0_ = ldsb + (unsigned)(bufoff) + ldsw, l1_ = l0_ + 8192u; unsigned m0s_; \
        asm volatile("s_mov_b32 %0, m0\n\ts_mov_b32 m0, %1\n\ts_nop 0\n\tglobal_load_lds_dwordx4 %3, %5\n\ts_mov_b32 m0, %2\n\ts_nop 0\n\tglobal_load_lds_dwordx4 %4, %5\n\ts_mov_b32 m0, %0" \
            : "=&s"(m0s_) : "s"(l0_), "s"(l1_), "v"((voff)[0]), "v"((voff)[1]), "s"((const char*)(gbase)) : "memory"); } while (0)
#define PG8_LDA(dst, b, h) do { _Pragma("unroll") for (int m = 0; m < 4; ++m) _Pragma("unroll") for (int k = 0; k < 2; ++k) dst[m][k] = *(const LAS bf16x8*)(lds + PG8_SA(b, h) + aoff + m * 2048 + k * 1024); } while (0)
#define PG8_LDB(dst, b, h) do { _Pragma("unroll") for (int n = 0; n < 2; ++n) _Pragma("unroll") for (int k = 0; k < 2; ++k) dst[n][k] = *(const LAS bf16x8*)(lds + PG8_SB(b, h) + boff + n * 2048 + k * 1024); } while (0)
#define PG8_MMA(ai, bj, At, Bt, Z) do { __builtin_amdgcn_s_setprio(1); _Pragma("unroll") for (int m = 0; m < 4; ++m) _Pragma("unroll") for (int n = 0; n < 2; ++n) _Pragma("unroll") for (int k = 0; k < 2; ++k) \
        acc[ai][bj][m][n] = __builtin_amdgcn_mfma_f32_16x16x32_bf16(Bt[n][k], At[m][k], ((Z) && k == 0) ? (f32x4){0.f, 0.f, 0.f, 0.f} : acc[ai][bj][m][n], 0, 0, 0); __builtin_amdgcn_s_setprio(0); } while (0)
#define PG8_WAIT_V(n) asm volatile("s_waitcnt vmcnt(" #n ")" ::: "memory")
#define PG8_WAIT_L(n) asm volatile("s_waitcnt lgkmcnt(" #n ")" ::: "memory")
#define PG8_BAR __builtin_amdgcn_s_barrier()
#define PG8_SCHED __builtin_amdgcn_sched_barrier(0)
    Unit cur, nxt; int ui = 0;
    if (!S.next(0, cur)) return;
    typename Epi::Pre pre;
    f32x4 acc[2][2][4][2];
    bf16x8 At[4][2], B0[2][2], B1[2][2];
    const char* cA = (const char*)g.A + (size_t)cur.pm * tstep; const char* cB = (const char*)g.Bt + (size_t)cur.pn * tstep;
    S.a_ready(cur);
    if constexpr (SP2) {
        PG8_STAGE(PG8_SB(0, 0), cB, voffB); PG8_STAGE(PG8_SB(0, 1), cB + hstep, voffB); PG8_STAGE(PG8_SA(0, 0), cA, voffA); PG8_STAGE(PG8_SA(0, 1), cA + hstep, voffA);
        if (wr == 1) PG8_BAR;
        PG8_WAIT_V(2); PG8_BAR;
        PG8_STAGE(PG8_SB(1, 0), cB + kstep, voffB); PG8_STAGE(PG8_SA(1, 0), cA + kstep, voffA); PG8_STAGE(PG8_SB(1, 1), cB + hstep + kstep, voffB);
        PG8_WAIT_V(6); PG8_BAR;
    } else {
        PG8_STAGE(PG8_SB(0, 0), cB, voffB); PG8_STAGE(PG8_SA(0, 0), cA, voffA); PG8_STAGE(PG8_SB(0, 1), cB + hstep, voffB); PG8_STAGE(PG8_SA(0, 1), cA + hstep, voffA);
        if (wr == 1) PG8_BAR;
        PG8_WAIT_V(4); PG8_BAR;
        PG8_STAGE(PG8_SB(1, 0), cB + kstep, voffB); PG8_STAGE(PG8_SA(1, 0), cA + kstep, voffA); PG8_STAGE(PG8_SB(1, 1), cB + hstep + kstep, voffB);
        PG8_WAIT_V(6); PG8_BAR;
    }
    for (;;) {
#define PG8_TRIP2(Z) { const bool last = !(Z) && (t == nt - 2);     \
            const char* a1 = cA + (size_t)(t + 1) * kstep; \
            const char* a2 = last ? nA : cA + (size_t)(t + 2) * kstep; const char* b2 = last ? nB : cB + (size_t)(t + 2) * kstep; \
            const char* a3 = a2 + kstep; const char* b3 = b2 + kstep; \
            if (last && has_next) S.a_ready(nxt); \
            if (last) E.prefetch(pre, cur, wr, opaque(threadIdx.x) & 63); \
            PG8_LDB(B0, 0, 0); PG8_LDB(B1, 0, 1); PG8_SCHED; PG8_LDA(At, 0, 0); PG8_STAGE(PG8_SA(1, 1), a1 + hstep, voffA); \
            PG8_WAIT_V(8); PG8_WAIT_L(0); PG8_BAR; PG8_MMA(0, 0, At, B0, Z); PG8_MMA(0, 1, At, B1, Z); PG8_BAR; PG8_SCHED; \
            PG8_LDA(At, 0, 1); PG8_STAGE(PG8_SB(0, 0), b2, voffB); PG8_STAGE(PG8_SB(0, 1), b2 + hstep, voffB); PG8_STAGE(PG8_SA(0, 0), a2, voffA); \
            PG8_WAIT_V(8); PG8_WAIT_L(0); PG8_BAR; PG8_MMA(1, 0, At, B0, Z); PG8_MMA(1, 1, At, B1, Z); PG8_BAR; PG8_SCHED; \
            PG8_LDB(B0, 1, 0); PG8_LDB(B1, 1, 1); PG8_SCHED; PG8_LDA(At, 1, 0); PG8_STAGE(PG8_SA(0, 1), a2 + hstep, voffA); \
            PG8_WAIT_V(8); PG8_WAIT_L(0); PG8_BAR; PG8_MMA(0, 0, At, B0, 0); PG8_MMA(0, 1, At, B1, 0); PG8_BAR; PG8_SCHED; \
            PG8_LDA(At, 1, 1); PG8_STAGE(PG8_SB(1, 0), b3, voffB); PG8_STAGE(PG8_SB(1, 1), b3 + hstep, voffB); PG8_STAGE(PG8_SA(1, 0), a3, voffA); \
            PG8_WAIT_V(8); PG8_WAIT_L(0); PG8_BAR; PG8_MMA(1, 0, At, B0, 0); PG8_MMA(1, 1, At, B1, 0); PG8_BAR; PG8_SCHED; }
        static_assert(SP2, "only the SP2 schedule is kept");
        bool has_next = false; const char* nA = cA; const char* nB = cB;
        { const int t = 0; PG8_TRIP2(1) }
        has_next = S.next(ui + 1, nxt);
        if (has_next) { nA = (const char*)g.A + (size_t)nxt.pm * tstep; nB = (const char*)g.Bt + (size_t)nxt.pn * tstep; }
        for (int t = 2; t < nt; t += 2) PG8_TRIP2(0)
#undef PG8_TRIP2
        if constexpr (ALIGN_EPI) { if (wr == 0) PG8_BAR; }
        if constexpr (!Epi::AFTER_DRAIN) { const int l2 = opaque(threadIdx.x) & 63; E(acc, cur, wr, wc, l2 & 15, l2 >> 4, pre); S.done(cur); }
        if (!has_next) break;
        cur = nxt; cA = nA; cB = nB; ++ui;
        if constexpr (ALIGN_EPI) { if (wr == 1) PG8_BAR; }
    }
    PG8_WAIT_V(0);
    if constexpr (!ALIGN_EPI) { if (wr == 0) PG8_BAR; }
    PG8_BAR;
#undef PG8_SA
#undef PG8_SB
#undef PG8_STAGE
#undef PG8_LDA
#undef PG8_LDB
#undef PG8_MMA
#undef PG8_WAIT_V
#undef PG8_WAIT_L
#undef PG8_BAR
#undef PG8_SCHED
}
}
#ifndef PG8_SP2
#define PG8_SP2 true
#endif
#ifndef PG8_ALIGN
#define PG8_ALIGN true
#endif

constexpr size_t MiB = (size_t)1 << 20;
constexpr size_t WS_CTL = 0, CTL_ZERO_BYTES = 16384;
constexpr size_t WS_WGU = 1 * MiB;
constexpr size_t WS_WDN = WS_WGU + 8 * 44 * MiB;
constexpr size_t WS_WABIN = WS_WDN + 8 * 22 * MiB;
constexpr size_t WS_WABOUT = WS_WABIN + 2 * 16 * MiB;
constexpr size_t WS_WCDIN = WS_WABOUT + 2 * 8 * MiB;
constexpr size_t WS_WCDOUT = WS_WCDIN + 2 * 29 * MiB;
constexpr size_t WS_WP = WS_WCDOUT + 2 * 8 * MiB;
constexpr size_t WS_XN = WS_WP + 16 * MiB;
constexpr size_t WS_ACT = WS_XN + 128 * MiB;
constexpr size_t WS_PROJ = WS_ACT + 352 * MiB;
constexpr size_t WS_YC = WS_PROJ + 464 * MiB;
constexpr size_t WS_SC = WS_YC + 128 * MiB;
constexpr size_t WS_BM = WS_SC + 512 * MiB;
constexpr size_t WS_KVT = WS_BM + 16 * MiB;
constexpr size_t WS_ST = WS_KVT + 128 * MiB;
constexpr size_t WS_IKW = WS_ST + 64 * MiB;
constexpr size_t WS_SSQ = WS_IKW + 16 * MiB;
constexpr size_t WS_RSTD = WS_SSQ + 4 * MiB;
constexpr size_t WS_END = WS_RSTD + 1 * MiB;

constexpr int LDS_MISC = 131072, LDS_BYTES = 131072 + 256;

__constant__ float ROPE_HI[32] = {1.591549367e-01f, 1.193493679e-01f, 8.949939907e-02f, 6.711508334e-02f, 5.032921210e-02f, 3.774158657e-02f, 2.830219641e-02f, 2.122365311e-02f, 1.591549441e-02f, 1.193493698e-02f, 8.949940093e-03f, 6.711508147e-03f, 5.032921210e-03f, 3.774158424e-03f, 2.830219688e-03f, 2.122365171e-03f, 1.591549488e-03f, 1.193493721e-03f, 8.949940093e-04f, 6.711508031e-04f, 5.032921326e-04f, 3.774158540e-04f, 2.830219455e-04f, 2.122365258e-04f, 1.591549371e-04f, 1.193493736e-04f, 8.949940093e-05f, 6.711508468e-05f, 5.032921035e-05f, 3.774158540e-05f, 2.830219637e-05f, 2.122365186e-05f};
__constant__ float ROPE_LO[32] = {6.420638243e-09f, 2.294664903e-09f, 2.542919653e-09f, -3.316028840e-10f, 5.173299289e-12f, -1.848551645e-09f, -5.826552019e-10f, -3.431038786e-10f, -1.029942312e-10f, 4.320196978e-11f, 6.802745173e-11f, 1.531042237e-10f, 5.173298855e-13f, 4.797548470e-11f, -1.048316503e-10f, 1.053879969e-10f, -5.686555046e-11f, -1.896286773e-11f, 6.802744999e-12f, 2.695195456e-11f, -1.158979943e-11f, -6.843983713e-12f, 1.279990003e-11f, 1.807650600e-12f, 5.954976963e-12f, -3.351478166e-12f, 6.802744674e-13f, -1.670379113e-12f, 1.751403167e-12f, -6.843983930e-13f, -5.389994549e-13f, 9.083608431e-13f};
__constant__ float L2G[8] = {-4.580368847e-02f, -2.272007614e-02f, -1.131531317e-02f, -5.646563135e-03f, -2.820519032e-03f, -1.409570221e-03f, -7.046129904e-04f, -3.522634797e-04f};

#define XB_TMO      128
#define XB_XCNT(j)  (256  + 64 * (j))
#define XB_XSUB(j)  (1280 + 64 * (j))
#define XB_XGEN(j)  (2304 + 64 * (j))
#define XB_TOP      3328
#define XB_TOPGEN   3392
#define XCD_BAR_WORDS 3456
#define XB_SPIN_CAP (1u << 22)
__device__ __forceinline__ unsigned xb_ld(unsigned* p)              { return __hip_atomic_load(p, __ATOMIC_RELAXED, __HIP_MEMORY_SCOPE_AGENT); }
__device__ __forceinline__ unsigned xb_add(unsigned* p, unsigned v) { return __hip_atomic_fetch_add(p, v, __ATOMIC_RELAXED, __HIP_MEMORY_SCOPE_AGENT); }
__device__ __forceinline__ unsigned xb_xcc_id() { return (unsigned)__builtin_amdgcn_s_getreg((3 << 11) | 20) & 0xFu; }
#define XB_SPIN(cond, bar) do { unsigned _sp = 0; while (cond) { __builtin_amdgcn_s_sleep(1); \
    if ((++_sp & 255u) == 0u) { if (xb_ld(&(bar)[XB_TMO])) break; if (_sp > XB_SPIN_CAP) { atomicAdd(&(bar)[XB_TMO], 1u); break; } } } } while (0)
struct XcdBarrier { unsigned* bar; unsigned x; volatile LAS unsigned* st; };
__device__ __forceinline__ XcdBarrier xcd_barrier_post(unsigned* bar, volatile LAS unsigned* st) {
    XcdBarrier b; b.bar = bar; b.x = xb_xcc_id(); b.st = st;
    if (threadIdx.x == 0) (void)xb_add(&bar[XB_XCNT(b.x)], 1u);
    return b;
}
__device__ __forceinline__ void xcd_barrier_complete(unsigned* bar, unsigned x, unsigned& nloc, unsigned& nx) {
    const unsigned G = gridDim.x * gridDim.y * gridDim.z;
    unsigned sum, cnt, mine, sp = 0u;
    for (;;) {
        sum = 0u; cnt = 0u; mine = 0u;
#pragma unroll
        for (unsigned j = 0; j < 16; ++j) { const unsigned c = xb_ld(&bar[XB_XCNT(j)]); sum += c; cnt += (c > 0u) ? 1u : 0u; mine = (j == x) ? c : mine; }
        if (sum == G) break;
        __builtin_amdgcn_s_sleep(1);
        if ((++sp & 255u) == 0u) { if (xb_ld(&bar[XB_TMO])) break; if (sp > XB_SPIN_CAP) { atomicAdd(&bar[XB_TMO], 1u); break; } }
    }
    nloc = mine > 0u ? mine : 1u; nx = cnt > 0u ? cnt : 1u;
}
__device__ __forceinline__ void xcd_barrier(const XcdBarrier& b) {
    asm volatile("s_waitcnt vmcnt(0)" ::: "memory");
    __syncthreads();
    if (threadIdx.x == 0) {
        unsigned* bar = b.bar;
        __builtin_amdgcn_s_waitcnt(0);
        unsigned nloc = b.st[0], nx = b.st[1];
        if (nloc == 0u) { xcd_barrier_complete(bar, b.x, nloc, nx); b.st[0] = nloc; b.st[1] = nx; }
        const unsigned old = xb_add(&bar[XB_XSUB(b.x)], 1u);
        const unsigned gen = old / nloc;
        if (old + 1u == (gen + 1u) * nloc) {
            __builtin_amdgcn_fence(__ATOMIC_RELEASE, "agent");
            asm volatile("s_waitcnt vmcnt(0)" ::: "memory");
            const unsigned og = xb_add(&bar[XB_TOP], 1u);
            const unsigned tg = og / nx;
            if (og + 1u == (tg + 1u) * nx) xb_add(&bar[XB_TOPGEN], 1u);
            else XB_SPIN(xb_ld(&bar[XB_TOPGEN]) == tg, bar);
            __builtin_amdgcn_fence(__ATOMIC_ACQUIRE, "agent");
            xb_add(&bar[XB_XGEN(b.x)], 1u);
            asm volatile("s_waitcnt vmcnt(0)" ::: "memory");
        } else {
            XB_SPIN(xb_ld(&bar[XB_XGEN(b.x)]) == gen, bar);
            __builtin_amdgcn_fence(__ATOMIC_ACQUIRE, "agent");
            asm volatile("s_waitcnt vmcnt(0)" ::: "memory");
        }
    }
    __syncthreads();
}

struct Ctx { LAS unsigned char* lds; unsigned ldsbase; int wave, G, bid, gw, NGW; };
#define TID_LANE() const int tid_ = opaque(threadIdx.x), lane_ = tid_ & 63
DI float wave_sum(float v, int lane) {
#pragma unroll
    for (int o = 1; o < 64; o <<= 1) v += __int_as_float(__builtin_amdgcn_ds_bpermute((lane ^ o) << 2, __float_as_int(v)));
    return v;
}
#define LDS_WAIT() asm volatile("s_waitcnt lgkmcnt(0)" ::: "memory")
#define SBAR() __builtin_amdgcn_sched_barrier(0)
DI int crow(int r, int hi) { return (r & 3) + 8 * (r >> 2) + 4 * hi; }
DI s16x4 tr_read(unsigned addr) { s16x4 r; asm volatile("ds_read_b64_tr_b16 %0, %1" : "=&v"(r) : "v"(addr) : "memory"); return r; }
#define MFMA32(a, b, c) __builtin_amdgcn_mfma_f32_32x32x16_bf16((a), (b), (c), 0, 0, 0)
#define CAT8(L, H) (bf16x8){L[0], L[1], L[2], L[3], H[0], H[1], H[2], H[3]}

DI void phase_fold(const Ctx& c, const float* pool_w, const float* pool_scale, const float* w_out, float* WP) {
    TID_LANE();
    for (int task = c.gw; task < 2 * 256 * 8; task += c.NGW) {
        const int nb = task & 7, kq = (task >> 3) & 255, l = task >> 11;
        const int k0 = kq * 4, g = k0 >> 8, c0 = k0 & 255;
        const float* pw = pool_w + ((size_t)(l * 4 + g) * 256 + c0) * 256;
        const float* ps = pool_scale + l * 1024 + g * 256;
        const float* wo = w_out + ((size_t)l * 2048 + 1024 + g * 256) * 2048 + nb * 256 + 4 * lane_;
        f32x4 a0 = {0.f, 0.f, 0.f, 0.f}, a1 = a0, a2 = a0, a3 = a0;
#pragma unroll 4
        for (int d = 0; d < 256; ++d) { const float s = ps[d]; const f32x4 b = *(const f32x4*)(wo + (size_t)d * 2048);
            a0 += (pw[d] * s) * b; a1 += (pw[256 + d] * s) * b; a2 += (pw[512 + d] * s) * b; a3 += (pw[768 + d] * s) * b; }
        float* o = WP + ((size_t)l * 1024 + k0) * 2048 + nb * 256 + 4 * lane_;
        *(f32x4*)o = a0; *(f32x4*)(o + 2048) = a1; *(f32x4*)(o + 4096) = a2; *(f32x4*)(o + 6144) = a3;
    }
}
DI int map_col(int map, int n) {
    if (map == 0) return n;
    if (map == 1) { const int tile = n >> 8, r = n & 255; return (r >> 7) * FF + tile * 128 + (r & 127); }
    if (n < 4096) return n;
    if (n < 7168) return n + 80;
    if (n < 7232) return n - 7168 + 4096;
    if (n < 7248) return n - 7232 + 4160;
    return -1;
}
DI void transpose_item(const float* src, int ld_src, int sc, bf16_t* dst, int ldd, int k0, int n0, LAS float* scr, int lane, const float* gk, float wscale) {
    const int kr = lane >> 3, n4 = (lane & 7) * 4;
    f32x4 v[8];
#pragma unroll
    for (int i = 0; i < 8; ++i) v[i] = (sc >= 0) ? *(const f32x4*)(src + (size_t)(k0 + 8 * i + kr) * ld_src + sc) : (f32x4){0.f, 0.f, 0.f, 0.f};
    if (gk) {
#pragma unroll
        for (int i = 0; i < 8; ++i) v[i] = v[i] * gk[k0 + 8 * i + kr]; }
    if (wscale != 1.0f) {
#pragma unroll
        for (int i = 0; i < 8; ++i) v[i] = v[i] * wscale; }
#pragma unroll
    for (int i = 0; i < 8; ++i) { LAS float* w = scr + (8 * i + kr) * 33 + n4; w[0] = v[i].x; w[1] = v[i].y; w[2] = v[i].z; w[3] = v[i].w; }
    LDS_WAIT(); asm volatile("" ::: "memory");
    const int cc = lane & 7;
#pragma unroll
    for (int j = 0; j < 4; ++j) { const int n = (lane >> 3) + 8 * j; const LAS float* s = scr + (8 * cc) * 33 + n;
        u32x4 o; o.x = pk2(s[0 * 33], s[1 * 33]); o.y = pk2(s[2 * 33], s[3 * 33]); o.z = pk2(s[4 * 33], s[5 * 33]); o.w = pk2(s[6 * 33], s[7 * 33]);
        *(u32x4*)(dst + (size_t)(n0 + n) * ldd + k0 + 8 * cc) = o; }
    LDS_WAIT(); asm volatile("" ::: "memory");
}
template <class KP> DI void phase_convert(const Ctx& c, KP ka, unsigned char* ws) {
    TID_LANE();
    LAS float* scr = (LAS float*)(c.lds + c.wave * 8448);
    for (int jj = 0; jj < 26; ++jj) { const int job = 25 - jj;
        const float* src; const float* gk = nullptr; float wscale = 1.0f; int ld_src, K, ldd, Ndst, koff = 0, map = 0; bf16_t* dst;
        if (job < 8)       { src = as_global(ka->in[2]) + (size_t)job * D * FF2; gk = as_global(ka->in[1]) + (size_t)((job >> 1) * 3 + (job & 1) * 2) * D; ld_src = FF2; K = D; Ndst = FF2; ldd = D; map = 1; dst = (bf16_t*)(ws + WS_WGU) + (size_t)job * FF2 * D; }
        else if (job < 16) { const int j = job - 8; wscale = 0.5f; src = as_global(ka->in[3]) + (size_t)j * FF * D;   ld_src = D; K = FF; Ndst = D; ldd = FF; dst = (bf16_t*)(ws + WS_WDN) + (size_t)j * D * FF; }
        else if (job < 18) { const int j = job - 16; src = as_global(ka->in[4]) + (size_t)j * D * ABIN; gk = as_global(ka->in[1]) + (size_t)((2 * j) * 3 + 1) * D; ld_src = ABIN; K = D; Ndst = ABIN; ldd = D; dst = (bf16_t*)(ws + WS_WABIN) + (size_t)j * ABIN * D; }
        else if (job < 20) { const int j = job - 18; src = as_global(ka->in[9]) + (size_t)j * D * CDIN; gk = as_global(ka->in[1]) + (size_t)((2 * j + 1) * 3 + 1) * D; ld_src = CDIN; K = D; Ndst = LDP; ldd = D; map = 2; dst = (bf16_t*)(ws + WS_WCDIN) + (size_t)j * LDP * D; }
        else if (job < 22) { const int j = job - 20; src = as_global(ka->in[8]) + (size_t)j * D * D; ld_src = D; K = 1024; Ndst = D; ldd = D; dst = (bf16_t*)(ws + WS_WABOUT) + (size_t)j * D * D; }
        else if (job < 24) { const int j = job - 22; src = (const float*)(ws + WS_WP) + (size_t)j * 1024 * D; ld_src = D; K = 1024; Ndst = D; ldd = D; koff = 1024; dst = (bf16_t*)(ws + WS_WABOUT) + (size_t)j * D * D; }
        else               { const int j = job - 24; src = as_global(ka->in[11]) + (size_t)j * D * D; ld_src = D; K = D; Ndst = D; ldd = D; dst = (bf16_t*)(ws + WS_WCDOUT) + (size_t)j * D * D; }
        const int nblk = Ndst / 32, nitems = (K / 64) * nblk;
        int w = c.gw + job * 797; w %= c.NGW;
        for (int it = w; it < nitems; it += c.NGW) {
            const int kb = it / nblk, nb = it - kb * nblk;
            const int sc = map_col(map, nb * 32 + (lane_ & 7) * 4);
            transpose_item(src, ld_src, sc, dst + koff, ldd, kb * 64, nb * 32, scr, lane_, gk, wscale);
        }
    }
}

DI void unpack8(const u32x4 w, float (&f)[8]) { f[0] = bflo(w.x); f[1] = bfhi(w.x); f[2] = bflo(w.y); f[3] = bfhi(w.y); f[4] = bflo(w.z); f[5] = bfhi(w.z); f[6] = bflo(w.w); f[7] = bfhi(w.w); }
DI u32x4 pack8(const float (&f)[8]) { u32x4 w; w.x = pk2(f[0], f[1]); w.y = pk2(f[2], f[3]); w.z = pk2(f[4], f[5]); w.w = pk2(f[6], f[7]); return w; }
DI void phase_first(const Ctx& c, const float* src, bf16_t* HBp, float* rstd) {
    TID_LANE();
    for (int m = c.gw; m < M; m += c.NGW) {
        const f32x4* xr = (const f32x4*)(src + (size_t)m * D) + lane_; f32x4 v[8]; float s = 0.f;
#pragma unroll
        for (int j = 0; j < 8; ++j) { v[j] = xr[64 * j]; s += (v[j].x * v[j].x + v[j].y * v[j].y) + (v[j].z * v[j].z + v[j].w * v[j].w); }
        s = wave_sum(s, lane_);
        if (lane_ == 0) rstd[m] = 1.0f / sqrtf(s * (1.0f / D) + 1e-6f);
        u32x2* o = (u32x2*)(HBp + (size_t)m * D) + lane_;
#pragma unroll
        for (int j = 0; j < 8; ++j) { u32x2 w; w.x = pk2(v[j].x, v[j].y); w.y = pk2(v[j].z, v[j].w); o[64 * j] = w; }
    }
}
DI void phase_rstd(const Ctx& c, const float* ssq, float* rstd) {
    const int gtid = c.bid * NTHREADS + opaque(threadIdx.x), NT_ = c.G * NTHREADS;
    for (int row = gtid; row < M; row += NT_) { const f32x4* p = (const f32x4*)(ssq + (size_t)row * 32); float s = 0.f;
#pragma unroll
        for (int k = 0; k < 8; ++k) { const f32x4 v = p[k]; s += (v.x + v.y) + (v.z + v.w); }
        rstd[row] = 1.0f / sqrtf(s * (1.0f / D) + 1e-6f); }
}
DI void phase_final_norm(const Ctx& c, const bf16_t* HBp, const float* gain, float* outp) {
    TID_LANE();
    for (int m = c.gw; m < M; m += c.NGW) {
        const u32x4* hr = (const u32x4*)(HBp + (size_t)m * D) + lane_; float h[4][8]; float s = 0.f;
#pragma unroll
        for (int j = 0; j < 4; ++j) { unpack8(hr[64 * j], h[j]);
#pragma unroll
            for (int k = 0; k < 8; ++k) s += h[j][k] * h[j][k]; }
        const float rstd = 1.0f / sqrtf(wave_sum(s, lane_) * (1.0f / D) + 1e-6f);
#pragma unroll
        for (int j = 0; j < 4; ++j) { const int col = (lane_ + 64 * j) * 8; const f32x4 g0 = *(const f32x4*)(gain + col), g1 = *(const f32x4*)(gain + col + 4);
            f32x4 o0 = {h[j][0] * rstd * g0.x, h[j][1] * rstd * g0.y, h[j][2] * rstd * g0.z, h[j][3] * rstd * g0.w}, o1 = {h[j][4] * rstd * g1.x, h[j][5] * rstd * g1.y, h[j][6] * rstd * g1.z, h[j][7] * rstd * g1.w};
            *(f32x4*)(outp + (size_t)m * D + col) = o0; *(f32x4*)(outp + (size_t)m * D + col + 4) = o1; }
    }
}

DI void phase_convpool(const Ctx& c, const bf16_t* PROJ, const float* conv_w, bf16_t* YC) {
    TID_LANE();
    const int half = lane_ >> 5, l32 = lane_ & 31;
    for (int task = c.gw; task < 4096; task += c.NGW) {
        const int ob = task & 7, rp = task >> 3;
        const int t0 = (rp * 2 + half) * 32, tpos0 = t0 & (T - 1);
        const int oct = ob * 32 + l32;
        if (ob < 4) {
            const int ch = oct * 8;
            float w0[8], w1[8], w2[8], up1[8], up2[8];
#pragma unroll
            for (int i = 0; i < 8; ++i) { w0[i] = conv_w[ch + i]; w1[i] = conv_w[1024 + ch + i]; w2[i] = conv_w[2048 + ch + i]; up1[i] = 0.f; up2[i] = 0.f; }
            if (tpos0 != 0) {
                float a[8], b[8];
                const bf16_t* r2 = PROJ + (size_t)(t0 - 2) * ABIN + ch; const bf16_t* r1 = r2 + ABIN;
                unpack8(*(const u32x4*)(r2 + 1024), a); unpack8(*(const u32x4*)(r2 + 2048), b);
#pragma unroll
                for (int i = 0; i < 8; ++i) up2[i] = a[i] * b[i];
                unpack8(*(const u32x4*)(r1 + 1024), a); unpack8(*(const u32x4*)(r1 + 2048), b);
#pragma unroll
                for (int i = 0; i < 8; ++i) up1[i] = a[i] * b[i];
            }
            for (int i = 0; i < 32; ++i) {
                const bf16_t* r = PROJ + (size_t)(t0 + i) * ABIN + ch;
                float bb[8], cc[8], hh[8], y[8];
                unpack8(*(const u32x4*)r, bb); unpack8(*(const u32x4*)(r + 1024), cc); unpack8(*(const u32x4*)(r + 2048), hh);
#pragma unroll
                for (int k = 0; k < 8; ++k) { const float u = cc[k] * hh[k]; y[k] = bb[k] * (w0[k] * up2[k] + w1[k] * up1[k] + w2[k] * u); up2[k] = up1[k]; up1[k] = u; }
                *(u32x4*)(YC + (size_t)(t0 + i) * D + ch) = pack8(y);
            }
        } else {
            const int g = ob - 4, w = 2 << g, ch = (oct - 128) * 8;
            const bf16_t* base = PROJ + 3072 + ch;
            float S[8];
#pragma unroll
            for (int k = 0; k < 8; ++k) S[k] = 0.f;
            if (tpos0 != 0) for (int s = t0 - w + 1; s < t0; ++s) { float x[8]; unpack8(*(const u32x4*)(base + (size_t)s * ABIN), x);
#pragma unroll
                for (int k = 0; k < 8; ++k) S[k] += x[k]; }
            for (int i = 0; i < 32; ++i) {
                const int row = t0 + i, tp = tpos0 + i;
                float x[8], y[8]; unpack8(*(const u32x4*)(base + (size_t)row * ABIN), x);
                const int cnt = (tp + 1) < w ? (tp + 1) : w; const float rc = 1.0f / (float)cnt;
#pragma unroll
                for (int k = 0; k < 8; ++k) { S[k] += x[k]; y[k] = S[k] * rc - x[k]; }
                *(u32x4*)(YC + (size_t)row * D + 1024 + ch) = pack8(y);
                if (tp - w + 1 >= 0) { float z[8]; unpack8(*(const u32x4*)(base + (size_t)(row - w + 1) * ABIN), z);
#pragma unroll
                    for (int k = 0; k < 8; ++k) S[k] -= z[k]; }
            }
        }
    }
}

constexpr int IXP = 72;
typedef _Float16 h2v __attribute__((ext_vector_type(2)));
typedef unsigned short us2v __attribute__((ext_vector_type(2)));
typedef short ss2v __attribute__((ext_vector_type(2)));
DI void indexer_wg(const Ctx& c, const bf16_t* PROJ, const bf16_t* IKWb, unsigned* SC, int b, int tg) {
    const int tid = opaque(threadIdx.x), lane = tid & 63, r32 = lane & 31, hi = lane >> 5, tl = r32 >> 4, h = r32 & 15;
    const int t0w = tg * 32 + c.wave * 4;
    const size_t rowbase = (size_t)b * T + t0w;
    bf16x8 A[2][4]; float w[2][2][8];
#pragma unroll
    for (int u = 0; u < 2; ++u)
#pragma unroll
        for (int ks = 0; ks < 4; ++ks) A[u][ks] = *(const bf16x8*)(PROJ + (rowbase + 2 * u + tl) * LDP + IQ + h * 64 + ks * 16 + hi * 8);
#pragma unroll
    for (int u = 0; u < 2; ++u)
#pragma unroll
        for (int t2 = 0; t2 < 2; ++t2)
#pragma unroll
            for (int i = 0; i < 8; ++i) w[u][t2][i] = (0.5f * 0.03125f) * bf1(IKWb[(rowbase + 2 * u + t2) * 256 + 64 + (i >> 2) * 8 + 4 * hi + (i & 3)]);
    const int vis_end = (((tg * 32) >> 6) + 1) << 6, nsteps = (vis_end + 255) >> 8;
    LAS bf16_t* buf = (LAS bf16_t*)c.lds;
    const bf16_t* kg = IKWb + (size_t)b * T * 256;
    u32x4 st[4];
#define IX_LOAD(s0) do { _Pragma("unroll") for (int k = 0; k < 4; ++k) { const int cc = tid + 512 * k, key = cc >> 3, part = cc & 7; \
        const int kk = ((s0) + key < vis_end) ? (s0) + key : vis_end - 1; st[k] = *(const u32x4*)(kg + (size_t)kk * 256 + part * 8); } } while (0)
#define IX_WRITE(bb) do { _Pragma("unroll") for (int k = 0; k < 4; ++k) { const int cc = tid + 512 * k, key = cc >> 3, part = cc & 7; \
        *(LAS u32x4*)(buf + (bb) * 256 * IXP + key * IXP + part * 8) = st[k]; } } while (0)
    __syncthreads();
    IX_LOAD(0); IX_WRITE(0); __syncthreads();
    for (int sp = 0; sp < nsteps; ++sp) {
        const int s0 = sp * 256, cur = sp & 1;
        if (sp + 1 < nsteps) IX_LOAD(s0 + 256);
        const int ngrp = (vis_end - s0) >= 256 ? 2 : ((vis_end - s0 + 127) >> 7);
        const LAS bf16_t* bb = buf + cur * 256 * IXP + r32 * IXP + hi * 8;
        for (int gt = 0; gt < 2 * ngrp; ++gt) {
            const int g = gt >> 1, tt = gt & 1;
            float sc[2][2];
            bf16x8 Bc[2][4];
#pragma unroll
            for (int pp = 0; pp < 2; ++pp)
#pragma unroll
                for (int ks = 0; ks < 4; ++ks) Bc[pp][ks] = *(const LAS bf16x8*)(bb + (4 * g + tt + 2 * pp) * 32 * IXP + ks * 16);
#define IX_CHAIN(acc, u, pp) do { _Pragma("unroll") for (int r = 0; r < 16; ++r) acc[r] = 0.f; _Pragma("unroll") for (int ks = 0; ks < 4; ++ks) acc = MFMA32(A[u][ks], Bc[pp][ks], acc); } while (0)
#define IX_VALU(acc, u, pp) do { float p0 = 0.f, p1 = 0.f; _Pragma("unroll") for (int r = 0; r < 8; ++r) { p0 = fmaf(fabsf(acc[r]), w[u][0][r], fmaf(acc[r], w[u][0][r], p0)); p1 = fmaf(fabsf(acc[8 + r]), w[u][1][r], fmaf(acc[8 + r], w[u][1][r], p1)); } \
        auto rr = __builtin_amdgcn_permlane32_swap(__float_as_uint(p0), __float_as_uint(p1), false, false); sc[u][pp] = __uint_as_float(rr[0]) + __uint_as_float(rr[1]); } while (0)
            f32x16 a0, a1, a2, a3;
            IX_CHAIN(a0, 0, 0); IX_CHAIN(a1, 1, 0); asm volatile("" : "+v"(a0), "+v"(a1));
            IX_CHAIN(a2, 0, 1); asm volatile("" : "+v"(a2)); IX_VALU(a0, 0, 0);
            IX_CHAIN(a3, 1, 1); asm volatile("" : "+v"(a3)); IX_VALU(a1, 1, 0);
            IX_VALU(a2, 0, 1); IX_VALU(a3, 1, 1);
#undef IX_CHAIN
#undef IX_VALU
#pragma unroll
            for (int u = 0; u < 2; ++u) { const h2v hv = {(_Float16)sc[u][0], (_Float16)sc[u][1]};
                SC[(rowbase + 2 * u + hi) * 2048 + (2 * sp + g) * 64 + tt * 32 + r32] = __builtin_bit_cast(unsigned, hv); }
        }
        if (sp + 1 < nsteps) IX_WRITE(cur ^ 1);
        __syncthreads();
    }
#undef IX_LOAD
#undef IX_WRITE
}

DI int wave_sum_i(int x) {
    x += __builtin_amdgcn_update_dpp(0, x, 0xB1, 0xf, 0xf, true);
    x += __builtin_amdgcn_update_dpp(0, x, 0x4E, 0xf, 0xf, true);
    x += __builtin_amdgcn_update_dpp(0, x, 0x141, 0xf, 0xf, true);
    x += __builtin_amdgcn_update_dpp(0, x, 0x140, 0xf, 0xf, true);
    return __builtin_amdgcn_readlane(x, 0) + __builtin_amdgcn_readlane(x, 16) + __builtin_amdgcn_readlane(x, 32) + __builtin_amdgcn_readlane(x, 48);
}
DI void cnt_gt4_pk(unsigned& a0, unsigned& a1, unsigned& a2, unsigned& a3, unsigned k0, unsigned k1, unsigned k2, unsigned k3, unsigned cc, unsigned one) {
    unsigned d0, d1, d2, d3;
    asm volatile("v_pk_sub_u16 %4, %8, %12 clamp\n\tv_pk_sub_u16 %5, %9, %12 clamp\n\tv_pk_sub_u16 %6, %10, %12 clamp\n\tv_pk_sub_u16 %7, %11, %12 clamp\n\t"
                 "v_pk_min_u16 %4, %4, %13\n\tv_pk_min_u16 %5, %5, %13\n\tv_pk_min_u16 %6, %6, %13\n\tv_pk_min_u16 %7, %7, %13\n\t"
                 "v_pk_add_u16 %0, %0, %4\n\tv_pk_add_u16 %1, %1, %5\n\tv_pk_add_u16 %2, %2, %6\n\tv_pk_add_u16 %3, %3, %7"
                 : "+v"(a0), "+v"(a1), "+v"(a2), "+v"(a3), "=&v"(d0), "=&v"(d1), "=&v"(d2), "=&v"(d3)
                 : "v"(k0), "v"(k1), "v"(k2), "v"(k3), "s"(cc), "v"(one));
}
template <int W> DI void emit4(int& mlo, int& mhi, int k0, int k1, int k2, int k3, int thr) {
    asm volatile("v_cmp_gt_i32_e64 s[88:89], %2, %6\n\tv_cmp_gt_i32_e64 s[90:91], %3, %6\n\tv_cmp_gt_i32_e64 s[92:93], %4, %6\n\tv_cmp_gt_i32_e64 s[94:95], %5, %6\n\ts_nop 1\n\t"
                 "v_writelane_b32 %0, s88, %7\n\tv_writelane_b32 %1, s89, %7\n\tv_writelane_b32 %0, s90, %8\n\tv_writelane_b32 %1, s91, %8\n\t"
                 "v_writelane_b32 %0, s92, %9\n\tv_writelane_b32 %1, s93, %9\n\tv_writelane_b32 %0, s94, %10\n\tv_writelane_b32 %1, s95, %10"
                 : "+v"(mlo), "+v"(mhi)
                 : "v"(k0), "v"(k1), "v"(k2), "v"(k3), "s"(thr), "n"(W), "n"(W + 1), "n"(W + 2), "n"(W + 3)
                 : "s88", "s89", "s90", "s91", "s92", "s93", "s94", "s95");
}
DI void phase_select(const Ctx& c, const unsigned* SC, unsigned long long* BM) {
    const int lane = opaque(threadIdx.x) & 63;
    unsigned nx[32]; unsigned one2 = 0x00010001u; asm volatile("" : "+v"(one2));
#define SEL_LOAD(row) do { const int np_ = (((((row) & (T - 1)) >> 6) + 1) + 1) >> 1; const unsigned* sr_ = SC + (size_t)(row) * 2048 + lane; \
        _Pragma("unroll") for (int j = 0; j < 32; ++j) nx[j] = sr_[64 * (j < np_ ? j : np_ - 1)]; } while (0)
    int row = c.gw;
    if (row < M) SEL_LOAD(row);
    for (; row < M; row += c.NGW) {
        const int t = row & (T - 1), nw = (t >> 6) + 1;
        unsigned key[32];
#pragma unroll
        for (int j = 0; j < 32; ++j) { const unsigned x = nx[j]; const ss2v sg = __builtin_bit_cast(ss2v, x) >> 15;
            const unsigned k = x ^ (__builtin_bit_cast(unsigned, sg) | 0x80008000u);
            const unsigned vm = ((2 * j < nw) ? 0xffffu : 0u) | ((2 * j + 1 < nw) ? 0xffff0000u : 0u); key[j] = k & vm; }
        if (row + c.NGW < M) SEL_LOAD(row + c.NGW);
        unsigned long long* bmr = BM + (size_t)row * 64;
        if (nw <= 4) { bmr[lane] = (lane < nw) ? ~0ull : 0ull; continue; }
        int prefix = 0, thr = 0; bool exact = false;
        for (int bit = 15; bit >= 0; --bit) {
            const int cand = prefix | (1 << bit), cm1 = cand - 1; const unsigned cc = (unsigned)__builtin_amdgcn_readfirstlane(cm1 * 0x10001);
            unsigned a0 = 0, a1 = 0, a2 = 0, a3 = 0;
#pragma unroll
            for (int j = 0; j < 32; j += 4) cnt_gt4_pk(a0, a1, a2, a3, key[j], key[j + 1], key[j + 2], key[j + 3], cc, one2);
            const unsigned as = (a0 + a1) + (a2 + a3);
            const int cnt = wave_sum_i((int)(as & 0xffffu) + (int)(as >> 16));
            if (cnt >= 256) prefix = cand;
            if (cnt == 256) { exact = true; thr = cm1; break; }
        }
        int need = 0;
        if (!exact) { thr = prefix; const unsigned cc = (unsigned)__builtin_amdgcn_readfirstlane(thr * 0x10001); unsigned a0 = 0, a1 = 0, a2 = 0, a3 = 0;
#pragma unroll
            for (int j = 0; j < 32; j += 4) cnt_gt4_pk(a0, a1, a2, a3, key[j], key[j + 1], key[j + 2], key[j + 3], cc, one2);
            const unsigned as = (a0 + a1) + (a2 + a3);
            need = 256 - wave_sum_i((int)(as & 0xffffu) + (int)(as >> 16)); }
        int mlo = 0, mhi = 0;
        { const int thr_s = __builtin_amdgcn_readfirstlane(thr);
#define EM4(W) emit4<W>(mlo, mhi, (int)(key[(W) / 2] & 0xffffu), (int)(key[(W) / 2] >> 16), (int)(key[(W) / 2 + 1] & 0xffffu), (int)(key[(W) / 2 + 1] >> 16), thr_s)
          EM4(0); EM4(4); EM4(8); EM4(12); EM4(16); EM4(20); EM4(24); EM4(28); EM4(32); EM4(36); EM4(40); EM4(44); EM4(48); EM4(52); EM4(56); EM4(60);
#undef EM4
        }
        if (need > 0) {
#pragma unroll
            for (int j = 0; j < 32; ++j) {
#pragma unroll
                for (int hh = 0; hh < 2; ++hh) { const int kk = hh ? (int)(key[j] >> 16) : (int)(key[j] & 0xffffu);
                    if (need > 0) { unsigned long long e = __ballot(kk == thr);
                        if (e) { int pc = __popcll(e); while (pc > need) { e &= ~(1ull << (63 - __clzll(e))); --pc; } need -= pc;
                            const unsigned long long m = __ballot(kk > thr) | e;
                            mlo = (lane == 2 * j + hh) ? (int)(unsigned)m : mlo; mhi = (lane == 2 * j + hh) ? (int)(unsigned)(m >> 32) : mhi; } } }
            }
        }
        const unsigned long long mine = ((unsigned long long)(unsigned)mhi << 32) | (unsigned)mlo;
        bmr[lane] = mine;
    }
#undef SEL_LOAD
}

namespace att {
constexpr float SCALE = 0.08838834764831845f, THR = 8.f, NEGM = -3.0e30f;
constexpr int SHM_V = 16384, SHM_K = 16384, OFF_V = 0, OFF_K = 32768, OFF_WS = 65536, OFF_LUT = 65536 + 2048, LDS_NEED = OFF_LUT + 2048;
#define KSWZ(row, colB) ((row) * 256 + ((colB) ^ (((row) & 7) << 4)))
DI void partialSM(f32x16& p0, f32x16& p1, float& m_reg, float& mn, float& alpha) {
    constexpr float C = SCALE * 1.4426950408889634f;
    float pmax = p0[0];
#pragma unroll
    for (int r = 1; r < 16; ++r) pmax = fmaxf(pmax, p0[r]);
#pragma unroll
    for (int r = 0; r < 16; ++r) pmax = fmaxf(pmax, p1[r]);
    { auto rr = __builtin_amdgcn_permlane32_swap(__float_as_uint(pmax), __float_as_uint(pmax), false, false);
      pmax = fmaxf(__uint_as_float(rr[0]), __uint_as_float(rr[1])); }
    if (__builtin_expect(__all(pmax - m_reg <= THR / SCALE), 1)) { mn = m_reg; alpha = 1.f; }
    else { mn = fmaxf(m_reg, pmax); alpha = fast_exp2((m_reg - mn) * C); m_reg = mn; }
    const float mnC = -mn * C;
#pragma unroll
    for (int r = 0; r < 16; ++r) p0[r] = fmaf(p0[r], C, mnC);
#pragma unroll
    for (int r = 0; r < 16; ++r) p1[r] = fmaf(p1[r], C, mnC);
#pragma unroll
    for (int r = 0; r < 16; ++r) p0[r] = fast_exp2(p0[r]);
}
DI void finishSM(f32x16& p0, f32x16& p1, float alpha, float& l_reg, bf16x8& pa0, bf16x8& pa1, bf16x8& pa2, bf16x8& pa3) {
#pragma unroll
    for (int r = 0; r < 16; ++r) p1[r] = fast_exp2(p1[r]);
    float ps = 0;
#pragma unroll
    for (int r = 0; r < 16; ++r) ps += p0[r];
#pragma unroll
    for (int r = 0; r < 16; ++r) ps += p1[r];
    { auto rr = __builtin_amdgcn_permlane32_swap(__float_as_uint(ps), __float_as_uint(ps), false, false);
      ps = __uint_as_float(rr[0]) + __uint_as_float(rr[1]); }
    l_reg = l_reg * alpha + ps;
#define PK4(P, BASE, OUT) do { unsigned a0 = pk2(P[BASE + 0], P[BASE + 1]), a1 = pk2(P[BASE + 2], P[BASE + 3]);   \
    unsigned b0 = pk2(P[BASE + 4], P[BASE + 5]), b1 = pk2(P[BASE + 6], P[BASE + 7]);                              \
    auto r0 = __builtin_amdgcn_permlane32_swap(a0, b0, false, false); auto r1 = __builtin_amdgcn_permlane32_swap(a1, b1, false, false); \
    u32x4 w = {r0[0], r1[0], r0[1], r1[1]}; OUT = __builtin_bit_cast(bf16x8, w); } while (0)
    PK4(p0, 0, pa0); PK4(p0, 8, pa1); PK4(p1, 0, pa2); PK4(p1, 8, pa3);
#undef PK4
}
DI bf16x8 lds_read128(unsigned addr) { bf16x8 r; asm volatile("ds_read_b128 %0, %1" : "=&v"(r) : "v"(addr) : "memory"); return r; }
DI void qkt(f32x16& p0, f32x16& p1, unsigned ks_addr  , const bf16x8* qr, int r32, int hi) {
    bf16x8 a0, a1, b0, b1;
#define QK_RD(d0, x0, x1) do { const int cb_ = ((d0) * 16 + hi * 8) * 2; x0 = lds_read128(ks_addr + (unsigned)KSWZ(r32, cb_)); x1 = lds_read128(ks_addr + (unsigned)KSWZ(32 + r32, cb_)); } while (0)
#define QK_MM(d0, x0, x1) do { p0 = MFMA32(x0, qr[d0], p0); p1 = MFMA32(x1, qr[d0], p1); } while (0)
    QK_RD(0, a0, a1);
    QK_RD(1, b0, b1); asm volatile("s_waitcnt lgkmcnt(2)" ::: "memory"); SBAR(); QK_MM(0, a0, a1); SBAR();
    QK_RD(2, a0, a1); asm volatile("s_waitcnt lgkmcnt(2)" ::: "memory"); SBAR(); QK_MM(1, b0, b1); SBAR();
    QK_RD(3, b0, b1); asm volatile("s_waitcnt lgkmcnt(2)" ::: "memory"); SBAR(); QK_MM(2, a0, a1); SBAR();
    QK_RD(4, a0, a1); asm volatile("s_waitcnt lgkmcnt(2)" ::: "memory"); SBAR(); QK_MM(3, b0, b1); SBAR();
    QK_RD(5, b0, b1); asm volatile("s_waitcnt lgkmcnt(2)" ::: "memory"); SBAR(); QK_MM(4, a0, a1); SBAR();
    QK_RD(6, a0, a1); asm volatile("s_waitcnt lgkmcnt(2)" ::: "memory"); SBAR(); QK_MM(5, b0, b1); SBAR();
    QK_RD(7, b0, b1); asm volatile("s_waitcnt lgkmcnt(2)" ::: "memory"); SBAR(); QK_MM(6, a0, a1); SBAR();
    asm volatile("s_waitcnt lgkmcnt(0)" ::: "memory"); SBAR(); QK_MM(7, b0, b1);
#undef QK_RD
#undef QK_MM
}
DI int v_st(int k, int c) { const int kk = (k & ~0xC) | ((k & 4) << 1) | ((k & 8) >> 1); return ((kk >> 3) * 4 + (c >> 5)) * 512 + ((kk & 7) * 32 + (c & 31)) * 2; }
DI int v_rd_base(int lane) { return ((lane & 3) << 3) | (((lane >> 2) & 3) << 6) | (((lane >> 4) & 1) << 5) | (((lane >> 5) & 1) << 8); }
constexpr int v_rd_off(int d0, int ks, int half) { return d0 * 512 + ks * 4096 + half * 2048; }
template <int OFF> DI s16x4 tr_read_o(int vb) { s16x4 r; asm volatile("ds_read_b64_tr_b16 %0, %1 offset:%2" : "=&v"(r) : "v"(vb), "i"(OFF) : "memory"); return r; }
template <int KS> DI void pv_reads(int vb, s16x4 (&l)[4], s16x4 (&h)[4]) {
    l[0] = tr_read_o<v_rd_off(0, KS, 0)>(vb); h[0] = tr_read_o<v_rd_off(0, KS, 1)>(vb); l[1] = tr_read_o<v_rd_off(1, KS, 0)>(vb); h[1] = tr_read_o<v_rd_off(1, KS, 1)>(vb);
    l[2] = tr_read_o<v_rd_off(2, KS, 0)>(vb); h[2] = tr_read_o<v_rd_off(2, KS, 1)>(vb); l[3] = tr_read_o<v_rd_off(3, KS, 0)>(vb); h[3] = tr_read_o<v_rd_off(3, KS, 1)>(vb);
}
DI void pv_mma(f32x16* o, bf16x8 pa, const s16x4 (&l)[4], const s16x4 (&h)[4]) {
    o[0] = MFMA32(pa, CAT8(l[0], h[0]), o[0]); o[1] = MFMA32(pa, CAT8(l[1], h[1]), o[1]); o[2] = MFMA32(pa, CAT8(l[2], h[2]), o[2]); o[3] = MFMA32(pa, CAT8(l[3], h[3]), o[3]);
}
DI void pv_d0(f32x16* o, int vb, bf16x8 pa0, bf16x8 pa1, bf16x8 pa2, bf16x8 pa3) {
    s16x4 la[4], ha[4], lb[4], hb[4];
    pv_reads<0>(vb, la, ha);
    pv_reads<1>(vb, lb, hb);
    asm volatile("s_waitcnt lgkmcnt(8)" ::: "memory"); SBAR(); pv_mma(o, pa0, la, ha); SBAR();
    pv_reads<2>(vb, la, ha);
    asm volatile("s_waitcnt lgkmcnt(8)" ::: "memory"); SBAR(); pv_mma(o, pa1, lb, hb); SBAR();
    pv_reads<3>(vb, lb, hb);
    asm volatile("s_waitcnt lgkmcnt(8)" ::: "memory"); SBAR(); pv_mma(o, pa2, la, ha); SBAR();
    asm volatile("s_waitcnt lgkmcnt(0)" ::: "memory"); SBAR(); pv_mma(o, pa3, lb, hb);
}
DI float sel_bits(unsigned w, int bit, float yes, float no) {
    const int m = __builtin_amdgcn_sbfe(w, bit, 1); float r;
    asm("v_bfi_b32 %0, %1, %2, %3" : "=v"(r) : "v"(m), "v"(yes), "v"(no));
    return r;
}
DI void mask_bias_init(f32x16& p0, f32x16& p1, unsigned long long mw, int j, int tpos, int hi, bool farj, float cb15, const LAS float* lut) {
    const unsigned lo = (unsigned)mw >> (4 * hi), hw = (unsigned)(mw >> 32) >> (4 * hi);
    if (farj) {
#pragma unroll
        for (int r = 0; r < 16; ++r) { const int cr = (r & 3) + 8 * (r >> 2);
            p0[r] = sel_bits(lo, cr, cb15, NEGM); p1[r] = sel_bits(hw, cr, cb15, NEGM); }
    } else {
        const LAS float* lp = lut + (64 * j - tpos + 256 + 4 * hi);
#pragma unroll
        for (int r = 0; r < 16; ++r) { const int cr = (r & 3) + 8 * (r >> 2); p0[r] = lp[cr]; p1[r] = lp[32 + cr]; }
        SBAR();
#pragma unroll
        for (int r = 0; r < 16; ++r) { const int cr = (r & 3) + 8 * (r >> 2);
            p0[r] = sel_bits(lo, cr, p0[r], NEGM); p1[r] = sel_bits(hw, cr, p1[r], NEGM); }
    }
}
DI void attn_unit(const Ctx& c, const bf16_t* Qb, const bf16_t* Kh, const bf16_t* Vh, bf16_t* Ob, const unsigned long long* bm, int q0, int NT, int h, const float* bias_table) {
    const int tid = opaque(threadIdx.x), wid = c.wave, lane = tid & 63, r32 = lane & 31, hi = lane >> 5;
    LAS char* lds = (LAS char*)c.lds;
    LAS char* V_lds = lds + OFF_V; LAS char* K_lds = lds + OFF_K;
    LAS float* wsf = (LAS float*)(lds + OFF_WS) + wid * 64; LAS float* li_l = wsf; LAS float* al_l = wsf + 32;
    LAS float* lut = (LAS float*)(lds + OFF_LUT);
    __syncthreads();
    { const int rel = tid - 256, n = rel < 0 ? -rel : rel;
      const int lg = n < 8 ? n : (n < 12 ? 8 : n < 16 ? 9 : n < 23 ? 10 : n < 32 ? 11 : n < 46 ? 12 : n < 64 ? 13 : n < 91 ? 14 : 15);
      lut[tid] = bias_table[((rel > 0 ? 16 : 0) + lg) * 8 + h] * 11.313708498984761f; }
    float m_reg = -1e30f, l_reg = 0; f32x16 o[4]; bf16x8 qr[8];
#pragma unroll
    for (int d = 0; d < 4; ++d)
#pragma unroll
        for (int r = 0; r < 16; ++r) o[d][r] = 0.f;
    const bf16_t* Qw = Qb + (size_t)(wid * 32 + r32) * LDP + hi * 8;
#pragma unroll
    for (int d0 = 0; d0 < 8; ++d0) qr[d0] = *(const bf16x8*)(Qw + d0 * 16);
    const int tpos = q0 + wid * 32 + r32;
    const unsigned long long* bmr = bm + (size_t)tpos * 64;
    const int sr = tid >> 4, sc = (tid & 15) * 8, vst0 = v_st(sr, sc), vst1 = v_st(32 + sr, sc);
    const int vb0 = (int)c.ldsbase + OFF_V + v_rd_base(lane);
    bf16x8 vs0, vs1, ks0, ks1;
#define SLOAD(k0) do { vs0 = *(const bf16x8*)(Vh + (size_t)((k0) + sr) * LDP + sc); vs1 = *(const bf16x8*)(Vh + (size_t)((k0) + 32 + sr) * LDP + sc); \
    ks0 = *(const bf16x8*)(Kh + (size_t)((k0) + sr) * LDP + sc); ks1 = *(const bf16x8*)(Kh + (size_t)((k0) + 32 + sr) * LDP + sc); } while (0)
#define SWRITE(b) do { *(LAS bf16x8*)(V_lds + (b) * SHM_V + vst0) = vs0; *(LAS bf16x8*)(V_lds + (b) * SHM_V + vst1) = vs1; const int kc = sc * 2; \
    *(LAS bf16x8*)(K_lds + (b) * SHM_K + KSWZ(sr, kc)) = ks0; *(LAS bf16x8*)(K_lds + (b) * SHM_K + KSWZ(32 + sr, kc)) = ks1; } while (0)
#define RESC(a) do { if (__any((a) < 1.f)) { if (hi == 0) al_l[r32] = (a); asm volatile("s_waitcnt lgkmcnt(0)" ::: "memory"); \
    _Pragma("unroll") for (int d = 0; d < 4; ++d) _Pragma("unroll") for (int r = 0; r < 16; ++r) o[d][r] *= al_l[crow(r, hi)]; } } while (0)
#define FARJ(j) ((64 * (j) + 154) <= (q0 + 32 * wid))
    f32x16 p0, p1; float mn, al; bf16x8 pa0, pa1, pa2, pa3;
    SLOAD(0);
    asm volatile("s_waitcnt vmcnt(0)" ::: "memory"); SWRITE(0); __syncthreads();
    const float cb15 = lut[0];
    unsigned long long mwn = bmr[0];
    for (int j = 0; j < NT; ++j) {
        const int bsel = j & 1;
        const unsigned long long mw = mwn;
        if (j + 1 < NT) { mwn = bmr[j + 1]; SLOAD((j + 1) * 64); }
        mask_bias_init(p0, p1, mw, j, tpos, hi, FARJ(j), cb15, lut);
        asm volatile("s_waitcnt lgkmcnt(0)" ::: "memory"); SBAR(); qkt(p0, p1, c.ldsbase + OFF_K + bsel * SHM_K, qr, r32, hi);
        partialSM(p0, p1, m_reg, mn, al);
        RESC(al);
        finishSM(p0, p1, al, l_reg, pa0, pa1, pa2, pa3); SBAR();
        pv_d0(o, vb0 + bsel * SHM_V, pa0, pa1, pa2, pa3);
        if (j + 1 < NT) { asm volatile("s_waitcnt vmcnt(0)" ::: "memory"); SWRITE(bsel ^ 1); }
        __syncthreads();
    }
    if (hi == 0) li_l[r32] = l_reg; asm volatile("s_waitcnt lgkmcnt(0)" ::: "memory");
    float rli[16];
#pragma unroll
    for (int r = 0; r < 16; ++r) rli[r] = __builtin_amdgcn_rcpf(li_l[crow(r, hi)]);
    bf16_t* Ow = Ob + (size_t)(wid * 32) * D;
#pragma unroll
    for (int r = 0; r < 16; ++r) { const int orow = crow(r, hi);
#pragma unroll
        for (int d0 = 0; d0 < 4; ++d0) Ow[(size_t)orow * D + d0 * 32 + r32] = (bf16_t)(pk2(o[d0][r] * rli[r], 0.f) & 0xffffu); }
#undef SLOAD
#undef SWRITE
#undef RESC
#undef FARJ
}
}

constexpr int RKP = 72, RVP = 136;
constexpr int R_OFF_Q = 0, R_OFF_K = 9216, R_OFF_V = 18432, R_OFF_S = 18432 + 17408, R_OFF_ST = R_OFF_S + 18432;
DI void stage_rope64(LAS bf16_t* img, const bf16_t* src, int tpos0, float mul, float l2g_dec, bool dec, int tid) {
    if (tid < 256) {
        const int j = tid >> 2, oc = tid & 3;
        float x1[8], x2[8], o1[8], o2[8];
        unpack8(*(const u32x4*)(src + (size_t)j * LDP + 8 * oc), x1); unpack8(*(const u32x4*)(src + (size_t)j * LDP + 32 + 8 * oc), x2);
        const float t = (float)(tpos0 + j);
        const float mm = dec ? mul * fast_exp2((float)(63 - j) * l2g_dec) : mul;
#pragma unroll
        for (int ii = 0; ii < 8; ++ii) { const int i = 8 * oc + ii;
            const float gh = ROPE_HI[i], gl = ROPE_LO[i];
            const float p = t * gh, e = fmaf(t, gh, -p); const float rev = (p - floorf(p)) + (e + t * gl);
            const float sn = __builtin_amdgcn_sinf(rev), cs = __builtin_amdgcn_cosf(rev);
            o1[ii] = (x1[ii] * cs - x2[ii] * sn) * mm; o2[ii] = (x1[ii] * sn + x2[ii] * cs) * mm; }
        *(LAS u32x4*)(img + j * RKP + 8 * oc) = pack8(o1); *(LAS u32x4*)(img + j * RKP + 32 + 8 * oc) = pack8(o2);
    }
}
DI void stage_v64(LAS bf16_t* img, const bf16_t* src, int tid) {
#pragma unroll
    for (int k = 0; k < 2; ++k) { const int cc = tid + 512 * k, j = cc >> 4, e8 = (cc & 15) * 8; *(LAS u32x4*)(img + j * RVP + e8) = *(const u32x4*)(src + (size_t)j * LDP + e8); }
}
DI void r1_unit(const Ctx& c, const bf16_t* PROJ, float* KVT, int unit) {
    const int b = unit >> 9, h = (unit >> 6) & 7, n = unit & 63;
    const size_t row0 = (size_t)b * T + n * 64;
    LAS bf16_t* Kimg = (LAS bf16_t*)(c.lds + R_OFF_K); LAS bf16_t* Vimg = (LAS bf16_t*)(c.lds + R_OFF_V);
    const int tid = opaque(threadIdx.x);
    __syncthreads();
    stage_rope64(Kimg, PROJ + row0 * LDP + RK + h * 64, n * 64, 0.125f, L2G[h], true, tid);
    stage_v64(Vimg, PROJ + row0 * LDP + RV + h * 128, tid);
    __syncthreads();
    const int lane = tid & 63, eb = c.wave >> 1, db = c.wave & 1, q = (lane >> 2) & 3, p = lane & 3, g1 = (lane >> 4) & 1, hi = lane >> 5, r32 = lane & 31;
    const unsigned aV = c.ldsbase + R_OFF_V + (unsigned)(((8 * hi + q) * RVP + 32 * eb + 16 * g1 + 4 * p) * 2);
    const unsigned aK = c.ldsbase + R_OFF_K + (unsigned)(((8 * hi + q) * RKP + 32 * db + 16 * g1 + 4 * p) * 2);
    s16x4 al[4], ah[4], bl[4], bh[4];
#pragma unroll
    for (int s = 0; s < 4; ++s) { al[s] = tr_read(aV + (unsigned)(16 * s * RVP * 2)); ah[s] = tr_read(aV + (unsigned)((16 * s + 4) * RVP * 2));
        bl[s] = tr_read(aK + (unsigned)(16 * s * RKP * 2)); bh[s] = tr_read(aK + (unsigned)((16 * s + 4) * RKP * 2)); }
    asm volatile("s_waitcnt lgkmcnt(0)" ::: "memory"); SBAR();
    f32x16 acc;
#pragma unroll
    for (int r = 0; r < 16; ++r) acc[r] = 0.f;
#pragma unroll
    for (int s = 0; s < 4; ++s) acc = MFMA32(CAT8(al[s], ah[s]), CAT8(bl[s], bh[s]), acc);
    float* o = KVT + (size_t)unit * 8192 + 32 * db + r32;
#pragma unroll
    for (int r = 0; r < 16; ++r) o[(32 * eb + crow(r, hi)) * 64] = acc[r];
}
DI void phase_scan(const Ctx& c, const float* KVT, bf16_t* ST) {
    const int gtid = c.bid * NTHREADS + opaque(threadIdx.x), NT_ = c.G * NTHREADS;
    for (int q = gtid; q < 64 * 2048; q += NT_) {
        const int bh = q >> 11, e4 = (q & 2047) * 4, h = bh & 7;
        const float cdec = fast_exp2(64.0f * L2G[h]);
        f32x4 S = {0.f, 0.f, 0.f, 0.f};
        const float* kp = KVT + (size_t)bh * 64 * 8192 + e4; bf16_t* sp = ST + (size_t)bh * 64 * 8192 + e4;
#pragma unroll 8
        for (int n = 0; n < 64; ++n) { u32x2 w; w.x = pk2(S.x, S.y); w.y = pk2(S.z, S.w); *(u32x2*)(sp + (size_t)n * 8192) = w;
            const f32x4 kv = *(const f32x4*)(kp + (size_t)n * 8192); S = S * cdec + kv; }
    }
}
DI void rope_write(LAS bf16_t* img, const u32x4 r1, const u32x4 r2, int t4, int tpos0, float mul) {
    const int j = t4 >> 2, oc = t4 & 3;
    float x1[8], x2[8], o1[8], o2[8];
    unpack8(r1, x1); unpack8(r2, x2);
    const float t = (float)(tpos0 + j);
#pragma unroll
    for (int ii = 0; ii < 8; ++ii) { const int i = 8 * oc + ii;
        const float gh = ROPE_HI[i], gl = ROPE_LO[i];
        const float p = t * gh, e = fmaf(t, gh, -p); const float rev = (p - floorf(p)) + (e + t * gl);
        const float sn = __builtin_amdgcn_sinf(rev), cs = __builtin_amdgcn_cosf(rev);
        o1[ii] = (x1[ii] * cs - x2[ii] * sn) * mul; o2[ii] = (x1[ii] * sn + x2[ii] * cs) * mul; }
    *(LAS u32x4*)(img + j * RKP + 8 * oc) = pack8(o1); *(LAS u32x4*)(img + j * RKP + 32 + 8 * oc) = pack8(o2);
}
DI void phase_r3(const Ctx& c, const bf16_t* PROJ, const bf16_t* ST, const float* gain, bf16_t* YC) {
    LAS bf16_t* Qimg = (LAS bf16_t*)(c.lds + R_OFF_Q); LAS bf16_t* Kimg = (LAS bf16_t*)(c.lds + R_OFF_K); LAS bf16_t* Vimg = (LAS bf16_t*)(c.lds + R_OFF_V); LAS bf16_t* Simg = (LAS bf16_t*)(c.lds + R_OFF_S);
    LAS f32x2* stat = (LAS f32x2*)(c.lds + R_OFF_ST);
    const int tid = opaque(threadIdx.x);
    const int lane = tid & 63, ib = c.wave & 1, eb = c.wave >> 1, q = (lane >> 2) & 3, p = lane & 3, g1 = (lane >> 4) & 1, hi = lane >> 5, r32 = lane & 31;
    const int iloc = 32 * ib + r32;
    const int t4 = tid & 255, isk = tid >> 8;
    u32x4 rq1, rq2, rv0, rv1, rs0, rs1;
#define R3_LOAD(unit) do { const int b_ = (unit) >> 9, h_ = ((unit) >> 6) & 7, n_ = (unit) & 63; const size_t row0_ = (size_t)b_ * T + n_ * 64; \
        const bf16_t* qk_ = PROJ + (row0_ + (t4 >> 2)) * LDP + (isk ? RK : RQ) + h_ * 64 + 8 * (t4 & 3); rq1 = *(const u32x4*)qk_; rq2 = *(const u32x4*)(qk_ + 32); \
        const bf16_t* v_ = PROJ + row0_ * LDP + RV + h_ * 128; rv0 = *(const u32x4*)(v_ + (size_t)(tid >> 4) * LDP + (tid & 15) * 8); rv1 = *(const u32x4*)(v_ + (size_t)(32 + (tid >> 4)) * LDP + (tid & 15) * 8); \
        const bf16_t* s_ = ST + (size_t)(unit) * 8192; rs0 = *(const u32x4*)(s_ + (tid >> 3) * 64 + (tid & 7) * 8); rs1 = *(const u32x4*)(s_ + (64 + (tid >> 3)) * 64 + (tid & 7) * 8); } while (0)
    int unit = c.bid;
    if (unit < 4096) R3_LOAD(unit);
    for (; unit < 4096; unit += c.G) {
        const int b = unit >> 9, h = (unit >> 6) & 7, n = unit & 63;
        const size_t row0 = (size_t)b * T + n * 64;
        const float l2g = L2G[h];
        __syncthreads();
        rope_write(isk ? Kimg : Qimg, rq1, rq2, t4, n * 64, isk ? 0.125f : 1.0f);
        *(LAS u32x4*)(Vimg + (tid >> 4) * RVP + (tid & 15) * 8) = rv0; *(LAS u32x4*)(Vimg + (32 + (tid >> 4)) * RVP + (tid & 15) * 8) = rv1;
        *(LAS u32x4*)(Simg + (tid >> 3) * RKP + (tid & 7) * 8) = rs0; *(LAS u32x4*)(Simg + (64 + (tid >> 3)) * RKP + (tid & 7) * 8) = rs1;
        __syncthreads();
        if (unit + c.G < 4096) R3_LOAD(unit + c.G);
        const size_t grow = row0 + iloc;
        u32x2 gw[4];
#pragma unroll
        for (int rg = 0; rg < 4; ++rg) gw[rg] = *(const u32x2*)(PROJ + grow * LDP + RG + h * 128 + 32 * eb + 8 * rg + 4 * hi);
        bf16x8 Bq[4];
#pragma unroll
        for (int ks = 0; ks < 4; ++ks) Bq[ks] = *(const LAS bf16x8*)(Qimg + iloc * RKP + 16 * ks + 8 * hi);
        bf16x8 Bx[2][2];
#pragma unroll
        for (int jb = 0; jb < 2; ++jb) {
            f32x16 a;
#pragma unroll
            for (int r = 0; r < 16; ++r) a[r] = 0.f;
#pragma unroll
            for (int ks = 0; ks < 4; ++ks) { const bf16x8 ak = *(const LAS bf16x8*)(Kimg + (32 * jb + r32) * RKP + 16 * ks + 8 * hi); a = MFMA32(ak, Bq[ks], a); }
#pragma unroll
            for (int r = 0; r < 16; ++r) { const int jl = 32 * jb + crow(r, hi); const int dd = iloc - jl; a[r] *= fast_exp2((float)(dd < 0 ? -dd : dd) * l2g); }
#pragma unroll
            for (int s2 = 0; s2 < 2; ++s2) { u32x4 w; w.x = pk2(a[8 * s2], a[8 * s2 + 1]); w.y = pk2(a[8 * s2 + 2], a[8 * s2 + 3]); w.z = pk2(a[8 * s2 + 4], a[8 * s2 + 5]); w.w = pk2(a[8 * s2 + 6], a[8 * s2 + 7]); Bx[jb][s2] = __builtin_bit_cast(bf16x8, w); }
        }
        const unsigned aV = c.ldsbase + R_OFF_V + (unsigned)(((4 * hi + q) * RVP + 32 * eb + 16 * g1 + 4 * p) * 2);
        s16x4 vl[4], vh[4];
#pragma unroll
        for (int u = 0; u < 4; ++u) { vl[u] = tr_read(aV + (unsigned)(16 * u * RVP * 2)); vh[u] = tr_read(aV + (unsigned)((16 * u + 8) * RVP * 2)); }
        asm volatile("s_waitcnt lgkmcnt(0)" ::: "memory"); SBAR();
        f32x16 oi, ox;
#pragma unroll
        for (int r = 0; r < 16; ++r) { oi[r] = 0.f; ox[r] = 0.f; }
#pragma unroll
        for (int u = 0; u < 4; ++u) oi = MFMA32(CAT8(vl[u], vh[u]), Bx[u >> 1][u & 1], oi);
#pragma unroll
        for (int ks = 0; ks < 4; ++ks) { const bf16x8 as = *(const LAS bf16x8*)(Simg + (32 * eb + r32) * RKP + 16 * ks + 8 * hi); ox = MFMA32(as, Bq[ks], ox); }
        const float qdec = fast_exp2((float)(iloc + 1) * l2g);
        float s1 = 0.f, s2 = 0.f;
#pragma unroll
        for (int r = 0; r < 16; ++r) { oi[r] = fmaf(ox[r], qdec, oi[r]); s1 += oi[r]; s2 += oi[r] * oi[r]; }
        { auto rr = __builtin_amdgcn_permlane32_swap(__float_as_uint(s1), __float_as_uint(s1), false, false); s1 = __uint_as_float(rr[0]) + __uint_as_float(rr[1]); }
        { auto rr = __builtin_amdgcn_permlane32_swap(__float_as_uint(s2), __float_as_uint(s2), false, false); s2 = __uint_as_float(rr[0]) + __uint_as_float(rr[1]); }
        if (hi == 0) stat[(ib * 4 + eb) * 32 + r32] = (f32x2){s1, s2};
        __syncthreads();
        float t1 = 0.f, t2 = 0.f;
#pragma unroll
        for (int k = 0; k < 4; ++k) { const f32x2 v = stat[(ib * 4 + k) * 32 + r32]; t1 += v.x; t2 += v.y; }
        const float mu = t1 * (1.0f / 128.0f), var = fmaxf(t2 * (1.0f / 128.0f) - mu * mu, 0.f), rstd = 1.0f / sqrtf(var + 1e-5f);
#pragma unroll
        for (int rg = 0; rg < 4; ++rg) { const int e0 = 32 * eb + 8 * rg + 4 * hi;
            const f32x4 gn = *(const f32x4*)(gain + h * 128 + e0);
            const float y0 = (oi[4 * rg] - mu) * rstd * gn.x * silu_f(bflo(gw[rg].x)), y1 = (oi[4 * rg + 1] - mu) * rstd * gn.y * silu_f(bfhi(gw[rg].x));
            const float y2 = (oi[4 * rg + 2] - mu) * rstd * gn.z * silu_f(bflo(gw[rg].y)), y3 = (oi[4 * rg + 3] - mu) * rstd * gn.w * silu_f(bfhi(gw[rg].y));
            u32x2 w; w.x = pk2(y0, y1); w.y = pk2(y2, y3);
            *(u32x2*)(YC + grow * D + 1024 + h * 128 + e0) = w; }
    }
#undef R3_LOAD
}

struct Params { const float* in[14]; float* out; unsigned char* wsp; int ph_lo, ph_hi; };
typedef const __attribute__((address_space(4))) Params* KArgP;
DI KArgP kargs() { KArgP p = (KArgP)__builtin_amdgcn_kernarg_segment_ptr(); asm volatile("" : "+s"(p)); return p; }
#define KA (kargs())
__global__ void __launch_bounds__(NTHREADS, 2) mk_fwd(Params P) {
#define ws (as_global(KA->wsp))
#define H (as_global(KA->out))
#define HB ((bf16_t*)(ws + WS_XN))
#define ACT ((bf16_t*)(ws + WS_ACT))
#define PROJ ((bf16_t*)(ws + WS_PROJ))
#define YC ((bf16_t*)(ws + WS_YC))
#define SC ((unsigned*)(ws + WS_SC))
#define BM ((unsigned long long*)(ws + WS_BM))
#define KVT ((float*)(ws + WS_KVT))
#define ST ((bf16_t*)(ws + WS_ST))
#define IKW ((bf16_t*)(ws + WS_IKW))
#define SSQ ((float*)(ws + WS_SSQ))
#define RSTD ((float*)(ws + WS_RSTD))
#define GAINS(l, k) (as_global(KA->in[1]) + (size_t)((l) * 3 + (k)) * D)
    extern __shared__ __attribute__((aligned(16))) unsigned char lds_raw[];
    Ctx c0;
    c0.lds = (LAS unsigned char*)lds_raw; c0.ldsbase = (unsigned)(uintptr_t)lds_raw;
    c0.wave = __builtin_amdgcn_readfirstlane((int)threadIdx.x >> 6);
    c0.G = gridDim.x; c0.bid = blockIdx.x; c0.gw = c0.bid * NWAVES + c0.wave; c0.NGW = c0.G * NWAVES;
    volatile LAS unsigned* misc = (volatile LAS unsigned*)(c0.lds + LDS_MISC);
    if (threadIdx.x < 16) misc[threadIdx.x] = 0u;
    __syncthreads();
    const int lo = P.ph_lo, hi = P.ph_hi;
    XcdBarrier bar; bar.bar = (unsigned*)(P.wsp + WS_CTL); bar.x = 0; bar.st = misc;
    if (hi - lo > 1) bar = xcd_barrier_post((unsigned*)(P.wsp + WS_CTL), misc);
    int pid = 0;
#define PH_BEGIN_K(k) if (pid >= lo && pid < hi) { for (int rep_ = 0; rep_ < (((k) >= 0 && ((MK_DUPMASK >> ((k) & 31)) & 1u)) ? 2 : 1); ++rep_) { if (rep_) xcd_barrier(bar); Ctx c = c0; asm volatile("" : "+s"(c.bid), "+s"(c.G), "+s"(c.gw), "+s"(c.NGW), "+s"(c.wave), "+s"(c.ldsbase));
#define PH_BEGIN PH_BEGIN_K(-2)
#define HOUT (rep_ ? (bf16_t*)(ws + WS_END) : HB)
#define SSQOUT (rep_ ? (float*)(ws + WS_END + 128 * MiB) : SSQ)
#define PH_END   } if (pid + 1 < hi) { xcd_barrier(bar); if (MK_XBAR) xcd_barrier(bar); } } ++pid;


    PH_BEGIN if (EN(0)) { phase_fold(c, as_global(KA->in[6]), as_global(KA->in[7]), as_global(KA->in[8]), (float*)(ws + WS_WP)); phase_first(c, as_global(KA->in[0]), HB, RSTD); } PH_END
    PH_BEGIN_K(1) if (EN(1)) phase_convert(c, KA, ws); PH_END

    for (int hs = 0; hs < 2 * DEPTH; ++hs) {
        const int L = hs >> 1, sub = hs & 1;
        if (hs != 0) { PH_BEGIN_K(2) if (EN(2)) phase_rstd(c, SSQ, RSTD); PH_END }
        PH_BEGIN_K(3) if (EN(3)) { pg8::Gemm g{HB, (const bf16_t*)(ws + WS_WGU) + (size_t)hs * FF2 * D, M, FF2, D}; pg8::StaticOrder S; S.init(M, FF2, c.G, c.bid);
                   pg8::EpiSwiglu E{ACT, FF, RSTD}; pg8::gemm_phase<pg8::EpiSwiglu, pg8::StaticOrder, PG8_ALIGN, PG8_SP2>(c.lds, g, S, E); } PH_END
        PH_BEGIN_K(4) if (EN(4)) { pg8::Gemm g{ACT, (const bf16_t*)(ws + WS_WDN) + (size_t)hs * D * FF, M, D, FF}; pg8::StaticOrder S; S.init(M, D, c.G, c.bid, 4, 1);
                   pg8::EpiResid E{HB, HOUT, D, SSQOUT}; pg8::gemm_phase<pg8::EpiResid, pg8::StaticOrder, PG8_ALIGN, PG8_SP2>(c.lds, g, S, E); } PH_END
        if (sub == 0) {
            const int j = L >> 1;
            PH_BEGIN_K(2) if (EN(2)) phase_rstd(c, SSQ, RSTD); PH_END
            if ((L & 1) == 0) {
                PH_BEGIN_K(5) if (EN(5)) { pg8::Gemm g{HB, (const bf16_t*)(ws + WS_WABIN) + (size_t)j * ABIN * D, M, ABIN, D}; pg8::StaticOrder S; S.init(M, ABIN, c.G, c.bid);
                           pg8::EpiStoreBf16 E{PROJ, ABIN, nullptr, -1, RSTD}; pg8::gemm_phase<pg8::EpiStoreBf16, pg8::StaticOrder, PG8_ALIGN, PG8_SP2>(c.lds, g, S, E); } PH_END
                PH_BEGIN_K(6) if (EN(6)) phase_convpool(c, PROJ, as_global(KA->in[5]) + (size_t)j * 3 * 1024, YC); PH_END
                PH_BEGIN_K(7) if (EN(7)) { pg8::Gemm g{YC, (const bf16_t*)(ws + WS_WABOUT) + (size_t)j * D * D, M, D, D}; pg8::StaticOrder S; S.init(M, D, c.G, c.bid, 4);
                           pg8::EpiResid E{HB, HOUT, D, SSQOUT}; pg8::gemm_phase<pg8::EpiResid, pg8::StaticOrder, PG8_ALIGN, PG8_SP2>(c.lds, g, S, E); } PH_END
            } else {
                PH_BEGIN_K(8) if (EN(8)) { pg8::Gemm g{HB, (const bf16_t*)(ws + WS_WCDIN) + (size_t)j * LDP * D, M, LDP, D}; pg8::StaticOrder S; S.init(M, LDP, c.G, c.bid);
                           pg8::EpiStoreBf16 E{PROJ, LDP, IKW, 28, RSTD}; pg8::gemm_phase<pg8::EpiStoreBf16, pg8::StaticOrder, PG8_ALIGN, PG8_SP2>(c.lds, g, S, E); } PH_END
                PH_BEGIN_K(9) {
                    REP2(9) for (int u = c.bid; u < 4096; u += c.G) r1_unit(c, PROJ, KVT, u);
                    REP2(10) for (int i = c.bid; i < 1024; i += c.G) { const int qd = i >> 8, v = i & 255, b = v >> 5, lw = v & 31;
                        const int tg = qd == 0 ? lw : (qd == 1 ? 63 - lw : (qd == 2 ? 64 + lw : 127 - lw));
                        indexer_wg(c, PROJ, IKW, SC, b, tg); }
                } PH_END
                PH_BEGIN_K(11) {
                    REP2(11) phase_select(c, SC, BM);
                    REP2(12) phase_scan(c, KVT, ST);
                } PH_END
                PH_BEGIN_K(13) {
                    REP2(13) for (int i = c.bid; i < 1024; i += c.G) { const int rnd = i >> 8, v = i & 255, bh = v >> 2, s = v & 3, b = bh >> 3, h = bh & 7;
                        const int qb = rnd == 0 ? s : (rnd == 1 ? 7 - s : (rnd == 2 ? 8 + s : 15 - s));
                        const size_t brow = (size_t)b * T;
                        att::attn_unit(c, PROJ + (brow + qb * 256) * LDP + CQ + h * 128, PROJ + brow * LDP + CK + h * 128, PROJ + brow * LDP + CV + h * 128,
                                       YC + (brow + qb * 256) * D + h * 128, BM + brow * 64, qb * 256, 4 * qb + 4, h, as_global(KA->in[12])); }
                    REP2(14) phase_r3(c, PROJ, ST, as_global(KA->in[10]) + (size_t)j * 1024, YC);
                } PH_END
                PH_BEGIN_K(15) if (EN(15)) { pg8::Gemm g{YC, (const bf16_t*)(ws + WS_WCDOUT) + (size_t)j * D * D, M, D, D}; pg8::StaticOrder S; S.init(M, D, c.G, c.bid, 4);
                           pg8::EpiResid E{HB, HOUT, D, SSQOUT}; pg8::gemm_phase<pg8::EpiResid, pg8::StaticOrder, PG8_ALIGN, PG8_SP2>(c.lds, g, S, E); } PH_END
            }
        }
    }
    PH_BEGIN if (EN(16)) phase_final_norm(c, HB, as_global(KA->in[13]), H); PH_END
#undef PH_BEGIN
#undef PH_BEGIN_K
#undef HOUT
#undef SSQOUT
#undef PH_END
#undef ws
#undef H
#undef HB
#undef ACT
#undef PROJ
#undef YC
#undef SC
#undef BM
#undef KVT
#undef ST
#undef IKW
#undef SSQ
#undef RSTD
#undef GAINS
}

constexpr int N_PHASES = 2 + 2 * DEPTH * 3 - 1 + 2 * (1 + 3) + 2 * (1 + 5) + 1;
extern "C" void kernel_launch(void* const* d_in, const int* in_sizes, int n_in, void* d_out, int out_size, void* d_ws, size_t ws_size, hipStream_t stream) {
    static int grid = 0;
    if (grid == 0) {
        if (n_in != 14 || out_size != M * D || ws_size < WS_END) { fprintf(stderr, "kernel_launch: unexpected shapes (n_in %d out %d ws %zu, need %zu)\n", n_in, out_size, ws_size, (size_t)WS_END); grid = -1; return; }
        int dev = 0, cus = 0, per_cu = 0;
        if (hipGetDevice(&dev) != hipSuccess || hipDeviceGetAttribute(&cus, hipDeviceAttributeMultiprocessorCount, dev) != hipSuccess) { grid = -1; return; }
        if (hipFuncSetAttribute((const void*)mk_fwd, hipFuncAttributeMaxDynamicSharedMemorySize, LDS_BYTES) != hipSuccess) { fprintf(stderr, "kernel_launch: hipFuncSetAttribute failed\n"); grid = -1; return; }
        if (hipOccupancyMaxActiveBlocksPerMultiprocessor(&per_cu, (const void*)mk_fwd, NTHREADS, LDS_BYTES) != hipSuccess || per_cu < 1) { fprintf(stderr, "kernel_launch: occupancy query says %d blocks per CU\n", per_cu); }
        (void)hipGetLastError();
        grid = cus;
    }
    if (grid < 0) return;
    (void)hipMemsetAsync((char*)d_ws + WS_CTL, 0, CTL_ZERO_BYTES, stream);
    Params p{};
    for (int i = 0; i < 14; ++i) p.in[i] = (const float*)d_in[i];
    p.out = (float*)d_out; p.wsp = (unsigned char*)d_ws;
#if MK_ONE_LAUNCH
    p.ph_lo = 0; p.ph_hi = N_PHASES;
    hipLaunchKernelGGL(mk_fwd, dim3(grid), dim3(NTHREADS), LDS_BYTES, stream, p);
#else
    for (int ph = 0; ph < N_PHASES; ++ph) { p.ph_lo = ph; p.ph_hi = ph + 1; hipLaunchKernelGGL(mk_fwd, dim3(grid), dim3(NTHREADS), LDS_BYTES, stream, p); }
#endif
    const hipError_t le = hipPeekAtLastError();
    if (le != hipSuccess) fprintf(stderr, "kernel_launch: launch failed: %s\n", hipGetErrorName(le));
}
```

```cpp
#include <hip/hip_runtime.h>
#include <cstdio>
#include <cstdint>

#ifndef MK_PHMASK
#define MK_PHMASK 0xffffffffu
#endif
#define EN(k) ((MK_PHMASK >> (k)) & 1u)
#ifndef MK_DUP2MASK
#define MK_DUP2MASK 0u
#endif
#define REP2(k) for (int r2_ = 0; r2_ < (((MK_DUP2MASK >> (k)) & 1u) ? 2 : 1); ++r2_)
#ifndef MK_XBAR
#define MK_XBAR 0
#endif
#ifndef MK_DUPMASK
#define MK_DUPMASK 0u
#endif
#ifndef MK_ONE_LAUNCH
#define MK_ONE_LAUNCH 1
#endif

#define DI __device__ __forceinline__
#define LAS __attribute__((address_space(3)))
typedef unsigned short bf16_t;
typedef short bf16x8 __attribute__((ext_vector_type(8)));
typedef short s16x4 __attribute__((ext_vector_type(4)));
typedef float f32x2 __attribute__((ext_vector_type(2)));
typedef float f32x4 __attribute__((ext_vector_type(4)));
typedef float f32x16 __attribute__((ext_vector_type(16)));
typedef unsigned u32x2 __attribute__((ext_vector_type(2)));
typedef unsigned u32x4 __attribute__((ext_vector_type(4)));
typedef __bf16 nbf2 __attribute__((ext_vector_type(2)));

#define GAS __attribute__((address_space(1)))
template <class T> DI T* as_global(T* p) { return (T*)(GAS T*)p; }
DI int opaque(int x) { asm volatile("" : "+v"(x)); return x; }
DI unsigned pk2(float lo, float hi) { nbf2 v = {(__bf16)lo, (__bf16)hi}; return __builtin_bit_cast(unsigned, v); }
DI float bflo(unsigned w) { return __uint_as_float(w << 16); }
DI float bfhi(unsigned w) { return __uint_as_float(w & 0xffff0000u); }
DI float bf1(bf16_t b) { return __uint_as_float(((unsigned)b) << 16); }
DI float fast_exp2(float x) { return __builtin_amdgcn_exp2f(x); }
DI float silu_f(float x) { return x * __builtin_amdgcn_rcpf(1.0f + fast_exp2(-1.4426950408889634f * x)); }

constexpr int BATCH = 8, T = 4096, D = 2048, M = BATCH * T, FF = 5632, FF2 = 2 * FF, DEPTH = 4;
constexpr int ABIN = 4096, CDIN = 7248, LDP = 7424;
constexpr int CQ = 0, CK = 1024, CV = 2048, IQ = 3072, RQ = 4096, RK = 4608, RV = 5120, RG = 6144, IK = 7168, IW = 7232;
constexpr int NWAVES = 8, NTHREADS = 512;

namespace pg8 {
constexpr int BM = 256, BK = 64, HALF = 128, HTB = HALF * BK * 2, STAGE_BYTES = 8 * HTB, NXCD = 8, WGM = 8;
__host__ __device__ __forceinline__ int lds_byte(int r, int c) { const int st = (r >> 4) * 2 + (c >> 5), rr = r & 15, cc = c & 31, ob = rr * 64 + cc * 2; return st * 1024 + (ob ^ (((ob >> 9) & 1) << 5)); }
__host__ __device__ __forceinline__ void stage_rc(int b, int& R, int& C) { const int st = b / 1024, sb = b % 1024, swz = sb ^ (((sb >> 9) & 1) << 5); R = (st >> 1) * 16 + swz / 64; C = (st & 1) * 32 + (swz % 64) / 2; }
__host__ __device__ __forceinline__ int perm32(int rho) { const int n = rho >> 4, i = rho & 15; return 8 * (i >> 2) + 4 * n + (i & 3); }
struct Unit { int pm, pn; };
struct Gemm { const bf16_t* A; const bf16_t* Bt; int M, N, K; };
struct StaticOrder {
    int nM, nN, nwg, G, c, wgm, rev;
    __host__ __device__ void init(int M_, int N_, int G_, int c_, int wgm_ = WGM, int rev_ = 0) { nM = M_ / BM; nN = N_ / BM; nwg = nM * nN; G = G_; c = c_; wgm = wgm_; rev = rev_; }
    __host__ __device__ bool next(int i, Unit& u) const {
        const long L = (long)i * G + c; if (L >= nwg) return false;
        int wgid = rev ? (nwg - 1 - (int)L) : (int)L; { const int q = nwg / NXCD, r = nwg % NXCD, xcd = wgid % NXCD, off = wgid / NXCD; wgid = (xcd < r ? xcd * (q + 1) : r * (q + 1) + (xcd - r) * q) + off; }
        const int nig = wgm * nN, gid = wgid / nig, fm = gid * wgm, gsz = (nM - fm) < wgm ? (nM - fm) : wgm;
        u.pm = fm + ((wgid % nig) % gsz); u.pn = (wgid % nig) / gsz; return true;
    }
    __device__ __forceinline__ void a_ready(const Unit&) const {}
    __device__ __forceinline__ void done(const Unit&) const {}
};
struct EpiStoreBf16 {
    static constexpr bool PERM = true, AFTER_DRAIN = false;
    bf16_t* O; int ldc; bf16_t* O2; int pn2; const float* rstd;
    struct Pre { float p0, p1; };
    __device__ __forceinline__ void prefetch(Pre& p, const Unit& u, int wr, int lane) const {
        const float* r = rstd + u.pm * BM + wr * 64 + lane; p.p0 = r[0]; p.p1 = r[HALF]; }
    __device__ __forceinline__ float rs_of(const Pre& p, int ai, int m, int fr) const {
        return __int_as_float(__builtin_amdgcn_ds_bpermute((16 * m + fr) << 2, __float_as_int(ai ? p.p1 : p.p0))); }
    __device__ __forceinline__ void operator()(const f32x4 (&acc)[2][2][4][2], const Unit& u, int wr, int wc, int fr, int fq, const Pre& pre) const {
        const bool alt = (u.pn == pn2);
        const int row0 = u.pm * BM + wr * 64 + fr, col0 = (alt ? 0 : u.pn * BM) + wc * 32 + 8 * fq;
        bf16_t* const Ob = alt ? O2 : O; const int ld = alt ? 256 : ldc;
        float rsv[8];
#pragma unroll
        for (int k = 0; k < 8; ++k) rsv[k] = rs_of(pre, k >> 2, k & 3, fr);
#pragma unroll
        for (int ai = 0; ai < 2; ++ai)
#pragma unroll
            for (int m = 0; m < 4; ++m) { const int row = row0 + ai * HALF + m * 16; const float rs = rsv[ai * 4 + m]; bf16_t* rowp = Ob + (size_t)row * ld + col0;
#pragma unroll
                for (int bj = 0; bj < 2; ++bj) { const f32x4 v0 = acc[ai][bj][m][0] * rs, v1 = acc[ai][bj][m][1] * rs;
                    u32x4 w; w.x = pk2(v0[0], v0[1]); w.y = pk2(v0[2], v0[3]); w.z = pk2(v1[0], v1[1]); w.w = pk2(v1[2], v1[3]);
                    *(u32x4*)(rowp + bj * HALF) = w; } }
    }
};
__device__ __forceinline__ void swiglu4(float (&p)[4], const f32x4 g, const f32x4 u, float k1, float irs2) {
    float t0, t1, t2, t3;
    asm("v_mul_f32 %4, %8, %16\n\tv_mul_f32 %5, %9, %16\n\tv_mul_f32 %6, %10, %16\n\tv_mul_f32 %7, %11, %16\n\t"
        "v_exp_f32 %4, %4\n\tv_exp_f32 %5, %5\n\tv_exp_f32 %6, %6\n\tv_exp_f32 %7, %7\n\t"
        "v_mul_f32 %0, %8, %12\n\tv_mul_f32 %1, %9, %13\n\tv_mul_f32 %2, %10, %14\n\tv_mul_f32 %3, %11, %15\n\t"
        "v_fma_f32 %4, %4, %17, %17\n\tv_fma_f32 %5, %5, %17, %17\n\tv_fma_f32 %6, %6, %17, %17\n\tv_fma_f32 %7, %7, %17, %17\n\t"
        "v_rcp_f32 %4, %4\n\tv_rcp_f32 %5, %5\n\tv_rcp_f32 %6, %6\n\tv_rcp_f32 %7, %7\n\t"
        "v_mul_f32 %0, %0, %4\n\tv_mul_f32 %1, %1, %5\n\tv_mul_f32 %2, %2, %6\n\tv_mul_f32 %3, %3, %7"
        : "=&v"(p[0]), "=&v"(p[1]), "=&v"(p[2]), "=&v"(p[3]), "=&v"(t0), "=&v"(t1), "=&v"(t2), "=&v"(t3)
        : "v"(g[0]), "v"(g[1]), "v"(g[2]), "v"(g[3]), "v"(u[0]), "v"(u[1]), "v"(u[2]), "v"(u[3]), "v"(k1), "v"(irs2));
}
struct EpiSwiglu {
    static constexpr bool PERM = true, AFTER_DRAIN = false;
    bf16_t* O; int ldc; const float* rstd;
    struct Pre { float p0, p1; };
    __device__ __forceinline__ void prefetch(Pre& p, const Unit& u, int wr, int lane) const {
        const float* r = rstd + u.pm * BM + wr * 64 + lane; p.p0 = r[0]; p.p1 = r[HALF]; }
    __device__ __forceinline__ float rs_of(const Pre& p, int ai, int m, int fr) const {
        return __int_as_float(__builtin_amdgcn_ds_bpermute((16 * m + fr) << 2, __float_as_int(ai ? p.p1 : p.p0))); }
    __device__ __forceinline__ void operator()(const f32x4 (&acc)[2][2][4][2], const Unit& u, int wr, int wc, int fr, int fq, const Pre& pre) const {
        const int row0 = u.pm * BM + wr * 64 + fr, col0 = u.pn * HALF + wc * 32 + 8 * fq;
        float rsv[8];
#pragma unroll
        for (int k = 0; k < 8; ++k) rsv[k] = rs_of(pre, k >> 2, k & 3, fr);
#pragma unroll
        for (int ai = 0; ai < 2; ++ai)
#pragma unroll
            for (int m = 0; m < 4; ++m) { const int row = row0 + ai * HALF + m * 16; const float rs = rsv[ai * 4 + m]; bf16_t* rowp = O + (size_t)row * ldc + col0;
                const float k1 = -1.4426950408889634f * rs, irs2 = __builtin_amdgcn_rcpf(rs * rs);
                const f32x4 g0 = acc[ai][0][m][0], g1 = acc[ai][0][m][1], u0 = acc[ai][1][m][0], u1 = acc[ai][1][m][1];
                float oa[4], ob[4];
                swiglu4(oa, g0, u0, k1, irs2); swiglu4(ob, g1, u1, k1, irs2);
                u32x4 w; w.x = pk2(oa[0], oa[1]); w.y = pk2(oa[2], oa[3]); w.z = pk2(ob[0], ob[1]); w.w = pk2(ob[2], ob[3]);
                *(u32x4*)rowp = w; }
    }
};
struct EpiResid {
    static constexpr bool PERM = true, AFTER_DRAIN = false;
    bf16_t* HBp; bf16_t* out; int ldc; float* ssq;
    struct Pre { };
    __device__ __forceinline__ void prefetch(Pre&, const Unit&, int, int) const {}
    __device__ __forceinline__ void operator()(const f32x4 (&acc)[2][2][4][2], const Unit& u, int wr, int wc, int fr, int fq, const Pre&) const {
        const int row0 = u.pm * BM + wr * 64 + fr, col0 = u.pn * BM + wc * 32 + 8 * fq;
        const int lane = fr + 16 * fq;
        u32x4 b[2][4][2];
#pragma unroll
        for (int ai = 0; ai < 2; ++ai)
#pragma unroll
            for (int m = 0; m < 4; ++m)
#pragma unroll
                for (int bj = 0; bj < 2; ++bj) b[ai][m][bj] = *(const u32x4*)(HBp + (size_t)(row0 + ai * HALF + m * 16) * ldc + col0 + bj * HALF);
#pragma unroll
        for (int ai = 0; ai < 2; ++ai) {
#pragma unroll
            for (int m = 0; m < 4; ++m) { const int row = row0 + ai * HALF + m * 16; float sq = 0.f;
#pragma unroll
                for (int bj = 0; bj < 2; ++bj) { const u32x4 w = b[ai][m][bj]; const f32x4 a0 = acc[ai][bj][m][0], a1 = acc[ai][bj][m][1];
                    const float h0 = bflo(w.x) + a0[0], h1 = bfhi(w.x) + a0[1], h2 = bflo(w.y) + a0[2], h3 = bfhi(w.y) + a0[3];
                    const float h4 = bflo(w.z) + a1[0], h5 = bfhi(w.z) + a1[1], h6 = bflo(w.w) + a1[2], h7 = bfhi(w.w) + a1[3];
                    sq += ((h0 * h0 + h1 * h1) + (h2 * h2 + h3 * h3)) + ((h4 * h4 + h5 * h5) + (h6 * h6 + h7 * h7));
                    u32x4 o; o.x = pk2(h0, h1); o.y = pk2(h2, h3); o.z = pk2(h4, h5); o.w = pk2(h6, h7);
                    *(u32x4*)(out + (size_t)row * ldc + col0 + bj * HALF) = o; }
                sq += __int_as_float(__builtin_amdgcn_ds_bpermute((lane ^ 16) << 2, __float_as_int(sq)));
                sq += __int_as_float(__builtin_amdgcn_ds_bpermute((lane ^ 32) << 2, __float_as_int(sq)));
                if (fq == 0) ssq[(size_t)row * 32 + u.pn * 4 + wc] = sq; }
            asm volatile("" ::: "memory"); }
    }
};

template <class Epi, class Sched, bool ALIGN_EPI = false, bool SP2 = false>
__device__ __forceinline__ void gemm_phase(LAS unsigned char* lds, const Gemm g, const Sched& S, const Epi& E) {
    const int tid = opaque(threadIdx.x), wid = __builtin_amdgcn_readfirstlane(tid >> 6), lane = tid & 63, wr = wid >> 2, wc = wid & 3, fr = lane & 15, fq = lane >> 4;
    const int K = g.K, nt = K / BK;
    unsigned voffA[2], voffB[2];
#pragma unroll
    for (int i = 0; i < 2; ++i) { int R, C; stage_rc(tid * 16 + i * 8192, R, C); const int Rb = Epi::PERM ? ((R & ~31) + perm32(R & 31)) : R;
        voffA[i] = (unsigned)(R * K + C) * 2u; voffB[i] = (unsigned)(Rb * K + C) * 2u; }
    const size_t kstep = (size_t)(BK * 2);
    const size_t hstep = (size_t)HALF * K * 2;
    const size_t tstep = 2 * hstep;
    const unsigned ldsw = (unsigned)wid * 1024u, ldsb = __builtin_amdgcn_readfirstlane((unsigned)(uintptr_t)lds);
    const int aoff = lds_byte(wr * 64 + fr, fq * 8), boff = lds_byte(wc * 32 + fr, fq * 8);
#define PG8_SA(b, h) (((b) * 2 + (h)) * HTB)
#define PG8_SB(b, h) ((4 + (b) * 2 + (h)) * HTB)
#define PG8_STAGE(bufoff, gbase, voff) do { const unsigned l0_ = ldsb + (unsigned)(bufoff) + ldsw, l1_ = l0_ + 8192u; unsigned m0s_; \
        asm volatile("s_mov_b32 %0, m0\n\ts_mov_b32 m0, %1\n\ts_nop 0\n\tglobal_load_lds_dwordx4 %3, %5\n\ts_mov_b32 m0, %2\n\ts_nop 0\n\tglobal_load_lds_dwordx4 %4, %5\n\ts_mov_b32 m0, %0" \
            : "=&s"(m0s_) : "s"(l0_), "s"(l1_), "v"((voff)[0]), "v"((voff)[1]), "s"((const char*)(gbase)) : "memory"); } while (0)
#define PG8_LDA(dst, b, h) do { _Pragma("unroll") for (int m = 0; m < 4; ++m) _Pragma("unroll") for (int k = 0; k < 2; ++k) dst[m][k] = *(const LAS bf16x8*)(lds + PG8_SA(b, h) + aoff + m * 2048 + k * 1024); } while (0)
#define PG8_LDB(dst, b, h) do { _Pragma("unroll") for (int n = 0; n < 2; ++n) _Pragma("unroll") for (int k = 0; k < 2; ++k) dst[n][k] = *(const LAS bf16x8*)(lds + PG8_SB(b, h) + boff + n * 2048 + k * 1024); } while (0)
#define PG8_MMA(ai, bj, At, Bt, Z) do { __builtin_amdgcn_s_setprio(1); _Pragma("unroll") for (int m = 0; m < 4; ++m) _Pragma("unroll") for (int n = 0; n < 2; ++n) _Pragma("unroll") for (int k = 0; k < 2; ++k) \
        acc[ai][bj][m][n] = __builtin_amdgcn_mfma_f32_16x16x32_bf16(Bt[n][k], At[m][k], ((Z) && k == 0) ? (f32x4){0.f, 0.f, 0.f, 0.f} : acc[ai][bj][m][n], 0, 0, 0); __builtin_amdgcn_s_setprio(0); } while (0)
#define PG8_WAIT_V(n) asm volatile("s_waitcnt vmcnt(" #n ")" ::: "memory")
#define PG8_WAIT_L(n) asm volatile("s_waitcnt lgkmcnt(" #n ")" ::: "memory")
#define PG8_BAR __builtin_amdgcn_s_barrier()
#define PG8_SCHED __builtin_amdgcn_sched_barrier(0)
    Unit cur, nxt; int ui = 0;
    if (!S.next(0, cur)) return;
    typename Epi::Pre pre;
    f32x4 acc[2][2][4][2];
    bf16x8 At[4][2], B0[2][2], B1[2][2];
    const char* cA = (const char*)g.A + (size_t)cur.pm * tstep; const char* cB = (const char*)g.Bt + (size_t)cur.pn * tstep;
    S.a_ready(cur);
    if constexpr (SP2) {
        PG8_STAGE(PG8_SB(0, 0), cB, voffB); PG8_STAGE(PG8_SB(0, 1), cB + hstep, voffB); PG8_STAGE(PG8_SA(0, 0), cA, voffA); PG8_STAGE(PG8_SA(0, 1), cA + hstep, voffA);
        if (wr == 1) PG8_BAR;
        PG8_WAIT_V(2); PG8_BAR;
        PG8_STAGE(PG8_SB(1, 0), cB + kstep, voffB); PG8_STAGE(PG8_SA(1, 0), cA + kstep, voffA); PG8_STAGE(PG8_SB(1, 1), cB + hstep + kstep, voffB);
        PG8_WAIT_V(6); PG8_BAR;
    } else {
        PG8_STAGE(PG8_SB(0, 0), cB, voffB); PG8_STAGE(PG8_SA(0, 0), cA, voffA); PG8_STAGE(PG8_SB(0, 1), cB + hstep, voffB); PG8_STAGE(PG8_SA(0, 1), cA + hstep, voffA);
        if (wr == 1) PG8_BAR;
        PG8_WAIT_V(4); PG8_BAR;
        PG8_STAGE(PG8_SB(1, 0), cB + kstep, voffB); PG8_STAGE(PG8_SA(1, 0), cA + kstep, voffA); PG8_STAGE(PG8_SB(1, 1), cB + hstep + kstep, voffB);
        PG8_WAIT_V(6); PG8_BAR;
    }
    for (;;) {
#define PG8_TRIP2(Z) { const bool last = !(Z) && (t == nt - 2);     \
            const char* a1 = cA + (size_t)(t + 1) * kstep; \
            const char* a2 = last ? nA : cA + (size_t)(t + 2) * kstep; const char* b2 = last ? nB : cB + (size_t)(t + 2) * kstep; \
            const char* a3 = a2 + kstep; const char* b3 = b2 + kstep; \
            if (last && has_next) S.a_ready(nxt); \
            if (last) E.prefetch(pre, cur, wr, opaque(threadIdx.x) & 63); \
            PG8_LDB(B0, 0, 0); PG8_LDB(B1, 0, 1); PG8_SCHED; PG8_LDA(At, 0, 0); PG8_STAGE(PG8_SA(1, 1), a1 + hstep, voffA); \
            PG8_WAIT_V(8); PG8_WAIT_L(0); PG8_BAR; PG8_MMA(0, 0, At, B0, Z); PG8_MMA(0, 1, At, B1, Z); PG8_BAR; PG8_SCHED; \
            PG8_LDA(At, 0, 1); PG8_STAGE(PG8_SB(0, 0), b2, voffB); PG8_STAGE(PG8_SB(0, 1), b2 + hstep, voffB); PG8_STAGE(PG8_SA(0, 0), a2, voffA); \
            PG8_WAIT_V(8); PG8_WAIT_L(0); PG8_BAR; PG8_MMA(1, 0, At, B0, Z); PG8_MMA(1, 1, At, B1, Z); PG8_BAR; PG8_SCHED; \
            PG8_LDB(B0, 1, 0); PG8_LDB(B1, 1, 1); PG8_SCHED; PG8_LDA(At, 1, 0); PG8_STAGE(PG8_SA(0, 1), a2 + hstep, voffA); \
            PG8_WAIT_V(8); PG8_WAIT_L(0); PG8_BAR; PG8_MMA(0, 0, At, B0, 0); PG8_MMA(0, 1, At, B1, 0); PG8_BAR; PG8_SCHED; \
            PG8_LDA(At, 1, 1); PG8_STAGE(PG8_SB(1, 0), b3, voffB); PG8_STAGE(PG8_SB(1, 1), b3 + hstep, voffB); PG8_STAGE(PG8_SA(1, 0), a3, voffA); \
            PG8_WAIT_V(8); PG8_WAIT_L(0); PG8_BAR; PG8_MMA(1, 0, At, B0, 0); PG8_MMA(1, 1, At, B1, 0); PG8_BAR; PG8_SCHED; }
        static_assert(SP2, "only the SP2 schedule is kept");
        bool has_next = false; const char* nA = cA; const char* nB = cB;
        { const int t = 0; PG8_TRIP2(1) }
        has_next = S.next(ui + 1, nxt);
        if (has_next) { nA = (const char*)g.A + (size_t)nxt.pm * tstep; nB = (const char*)g.Bt + (size_t)nxt.pn * tstep; }
        for (int t = 2; t < nt; t += 2) PG8_TRIP2(0)
#undef PG8_TRIP2
        if constexpr (ALIGN_EPI) { if (wr == 0) PG8_BAR; }
        if constexpr (!Epi::AFTER_DRAIN) { const int l2 = opaque(threadIdx.x) & 63; E(acc, cur, wr, wc, l2 & 15, l2 >> 4, pre); S.done(cur); }
        if (!has_next) break;
        cur = nxt; cA = nA; cB = nB; ++ui;
        if constexpr (ALIGN_EPI) { if (wr == 1) PG8_BAR; }
    }
    PG8_WAIT_V(0);
    if constexpr (!ALIGN_EPI) { if (wr == 0) PG8_BAR; }
    PG8_BAR;
#undef PG8_SA
#undef PG8_SB
#undef PG8_STAGE
#undef PG8_LDA
#undef PG8_LDB
#undef PG8_MMA
#undef PG8_WAIT_V
#undef PG8_WAIT_L
#undef PG8_BAR
#undef PG8_SCHED
}
}
#ifndef PG8_SP2
#define PG8_SP2 true
#endif
#ifndef PG8_ALIGN
#define PG8_ALIGN true
#endif

constexpr size_t MiB = (size_t)1 << 20;
constexpr size_t WS_CTL = 0, CTL_ZERO_BYTES = 16384;
constexpr size_t WS_WGU = 1 * MiB;
constexpr size_t WS_WDN = WS_WGU + 8 * 44 * MiB;
constexpr size_t WS_WABIN = WS_WDN + 8 * 22 * MiB;
constexpr size_t WS_WABOUT = WS_WABIN + 2 * 16 * MiB;
constexpr size_t WS_WCDIN = WS_WABOUT + 2 * 8 * MiB;
constexpr size_t WS_WCDOUT = WS_WCDIN + 2 * 29 * MiB;
constexpr size_t WS_WP = WS_WCDOUT + 2 * 8 * MiB;
constexpr size_t WS_XN = WS_WP + 16 * MiB;
constexpr size_t WS_ACT = WS_XN + 128 * MiB;
constexpr size_t WS_PROJ = WS_ACT + 352 * MiB;
constexpr size_t WS_YC = WS_PROJ + 464 * MiB;
constexpr size_t WS_SC = WS_YC + 128 * MiB;
constexpr size_t WS_BM = WS_SC + 512 * MiB;
constexpr size_t WS_KVT = WS_BM + 16 * MiB;
constexpr size_t WS_ST = WS_KVT + 128 * MiB;
constexpr size_t WS_IKW = WS_ST + 64 * MiB;
constexpr size_t WS_SSQ = WS_IKW + 16 * MiB;
constexpr size_t WS_RSTD = WS_SSQ + 4 * MiB;
constexpr size_t WS_END = WS_RSTD + 1 * MiB;

constexpr int LDS_MISC = 131072, LDS_BYTES = 131072 + 256;

__constant__ float ROPE_HI[32] = {1.591549367e-01f, 1.193493679e-01f, 8.949939907e-02f, 6.711508334e-02f, 5.032921210e-02f, 3.774158657e-02f, 2.830219641e-02f, 2.122365311e-02f, 1.591549441e-02f, 1.193493698e-02f, 8.949940093e-03f, 6.711508147e-03f, 5.032921210e-03f, 3.774158424e-03f, 2.830219688e-03f, 2.122365171e-03f, 1.591549488e-03f, 1.193493721e-03f, 8.949940093e-04f, 6.711508031e-04f, 5.032921326e-04f, 3.774158540e-04f, 2.830219455e-04f, 2.122365258e-04f, 1.591549371e-04f, 1.193493736e-04f, 8.949940093e-05f, 6.711508468e-05f, 5.032921035e-05f, 3.774158540e-05f, 2.830219637e-05f, 2.122365186e-05f};
__constant__ float ROPE_LO[32] = {6.420638243e-09f, 2.294664903e-09f, 2.542919653e-09f, -3.316028840e-10f, 5.173299289e-12f, -1.848551645e-09f, -5.826552019e-10f, -3.431038786e-10f, -1.029942312e-10f, 4.320196978e-11f, 6.802745173e-11f, 1.531042237e-10f, 5.173298855e-13f, 4.797548470e-11f, -1.048316503e-10f, 1.053879969e-10f, -5.686555046e-11f, -1.896286773e-11f, 6.802744999e-12f, 2.695195456e-11f, -1.158979943e-11f, -6.843983713e-12f, 1.279990003e-11f, 1.807650600e-12f, 5.954976963e-12f, -3.351478166e-12f, 6.802744674e-13f, -1.670379113e-12f, 1.751403167e-12f, -6.843983930e-13f, -5.389994549e-13f, 9.083608431e-13f};
__constant__ float L2G[8] = {-4.580368847e-02f, -2.272007614e-02f, -1.131531317e-02f, -5.646563135e-03f, -2.820519032e-03f, -1.409570221e-03f, -7.046129904e-04f, -3.522634797e-04f};

#define XB_TMO      128
#define XB_XCNT(j)  (256  + 64 * (j))
#define XB_XSUB(j)  (1280 + 64 * (j))
#define XB_XGEN(j)  (2304 + 64 * (j))
#define XB_TOP      3328
#define XB_TOPGEN   3392
#define XCD_BAR_WORDS 3456
#define XB_SPIN_CAP (1u << 22)
__device__ __forceinline__ unsigned xb_ld(unsigned* p)              { return __hip_atomic_load(p, __ATOMIC_RELAXED, __HIP_MEMORY_SCOPE_AGENT); }
__device__ __forceinline__ unsigned xb_add(unsigned* p, unsigned v) { return __hip_atomic_fetch_add(p, v, __ATOMIC_RELAXED, __HIP_MEMORY_SCOPE_AGENT); }
__device__ __forceinline__ unsigned xb_xcc_id() { return (unsigned)__builtin_amdgcn_s_getreg((3 << 11) | 20) & 0xFu; }
#define XB_SPIN(cond, bar) do { unsigned _sp = 0; while (cond) { __builtin_amdgcn_s_sleep(1); \
    if ((++_sp & 255u) == 0u) { if (xb_ld(&(bar)[XB_TMO])) break; if (_sp > XB_SPIN_CAP) { atomicAdd(&(bar)[XB_TMO], 1u); break; } } } } while (0)
struct XcdBarrier { unsigned* bar; unsigned x; volatile LAS unsigned* st; };
__device__ __forceinline__ XcdBarrier xcd_barrier_post(unsigned* bar, volatile LAS unsigned* st) {
    XcdBarrier b; b.bar = bar; b.x = xb_xcc_id(); b.st = st;
    if (threadIdx.x == 0) (void)xb_add(&bar[XB_XCNT(b.x)], 1u);
    return b;
}
__device__ __forceinline__ void xcd_barrier_complete(unsigned* bar, unsigned x, unsigned& nloc, unsigned& nx) {
    const unsigned G = gridDim.x * gridDim.y * gridDim.z;
    unsigned sum, cnt, mine, sp = 0u;
    for (;;) {
        sum = 0u; cnt = 0u; mine = 0u;
#pragma unroll
        for (unsigned j = 0; j < 16; ++j) { const unsigned c = xb_ld(&bar[XB_XCNT(j)]); sum += c; cnt += (c > 0u) ? 1u : 0u; mine = (j == x) ? c : mine; }
        if (sum == G) break;
        __builtin_amdgcn_s_sleep(1);
        if ((++sp & 255u) == 0u) { if (xb_ld(&bar[XB_TMO])) break; if (sp > XB_SPIN_CAP) { atomicAdd(&bar[XB_TMO], 1u); break; } }
    }
    nloc = mine > 0u ? mine : 1u; nx = cnt > 0u ? cnt : 1u;
}
__device__ __forceinline__ void xcd_barrier(const XcdBarrier& b) {
    asm volatile("s_waitcnt vmcnt(0)" ::: "memory");
    __syncthreads();
    if (threadIdx.x == 0) {
        unsigned* bar = b.bar;
        __builtin_amdgcn_s_waitcnt(0);
        unsigned nloc = b.st[0], nx = b.st[1];
        if (nloc == 0u) { xcd_barrier_complete(bar, b.x, nloc, nx); b.st[0] = nloc; b.st[1] = nx; }
        const unsigned old = xb_add(&bar[XB_XSUB(b.x)], 1u);
        const unsigned gen = old / nloc;
        if (old + 1u == (gen + 1u) * nloc) {
            __builtin_amdgcn_fence(__ATOMIC_RELEASE, "agent");
            asm volatile("s_waitcnt vmcnt(0)" ::: "memory");
            const unsigned og = xb_add(&bar[XB_TOP], 1u);
            const unsigned tg = og / nx;
            if (og + 1u == (tg + 1u) * nx) xb_add(&bar[XB_TOPGEN], 1u);
            else XB_SPIN(xb_ld(&bar[XB_TOPGEN]) == tg, bar);
            __builtin_amdgcn_fence(__ATOMIC_ACQUIRE, "agent");
            xb_add(&bar[XB_XGEN(b.x)], 1u);
            asm volatile("s_waitcnt vmcnt(0)" ::: "memory");
        } else {
            XB_SPIN(xb_ld(&bar[XB_XGEN(b.x)]) == gen, bar);
            __builtin_amdgcn_fence(__ATOMIC_ACQUIRE, "agent");
            asm volatile("s_waitcnt vmcnt(0)" ::: "memory");
        }
    }
    __syncthreads();
}

struct Ctx { LAS unsigned char* lds; unsigned ldsbase; int wave, G, bid, gw, NGW; };
#define TID_LANE() const int tid_ = opaque(threadIdx.x), lane_ = tid_ & 63
DI float wave_sum(float v, int lane) {
#pragma unroll
    for (int o = 1; o < 64; o <<= 1) v += __int_as_float(__builtin_amdgcn_ds_bpermute((lane ^ o) << 2, __float_as_int(v)));
    return v;
}
#define LDS_WAIT() asm volatile("s_waitcnt lgkmcnt(0)" ::: "memory")
#define SBAR() __builtin_amdgcn_sched_barrier(0)
DI int crow(int r, int hi) { return (r & 3) + 8 * (r >> 2) + 4 * hi; }
DI s16x4 tr_read(unsigned addr) { s16x4 r; asm volatile("ds_read_b64_tr_b16 %0, %1" : "=&v"(r) : "v"(addr) : "memory"); return r; }
#define MFMA32(a, b, c) __builtin_amdgcn_mfma_f32_32x32x16_bf16((a), (b), (c), 0, 0, 0)
#define CAT8(L, H) (bf16x8){L[0], L[1], L[2], L[3], H[0], H[1], H[2], H[3]}

DI void phase_fold(const Ctx& c, const float* pool_w, const float* pool_scale, const float* w_out, float* WP) {
    TID_LANE();
    for (int task = c.gw; task < 2 * 256 * 8; task += c.NGW) {
        const int nb = task & 7, kq = (task >> 3) & 255, l = task >> 11;
        const int k0 = kq * 4, g = k0 >> 8, c0 = k0 & 255;
        const float* pw = pool_w + ((size_t)(l * 4 + g) * 256 + c0) * 256;
        const float* ps = pool_scale + l * 1024 + g * 256;
        const float* wo = w_out + ((size_t)l * 2048 + 1024 + g * 256) * 2048 + nb * 256 + 4 * lane_;
        f32x4 a0 = {0.f, 0.f, 0.f, 0.f}, a1 = a0, a2 = a0, a3 = a0;
#pragma unroll 4
        for (int d = 0; d < 256; ++d) { const float s = ps[d]; const f32x4 b = *(const f32x4*)(wo + (size_t)d * 2048);
            a0 += (pw[d] * s) * b; a1 += (pw[256 + d] * s) * b; a2 += (pw[512 + d] * s) * b; a3 += (pw[768 + d] * s) * b; }
        float* o = WP + ((size_t)l * 1024 + k0) * 2048 + nb * 256 + 4 * lane_;
        *(f32x4*)o = a0; *(f32x4*)(o + 2048) = a1; *(f32x4*)(o + 4096) = a2; *(f32x4*)(o + 6144) = a3;
    }
}
DI int map_col(int map, int n) {
    if (map == 0) return n;
    if (map == 1) { const int tile = n >> 8, r = n & 255; return (r >> 7) * FF + tile * 128 + (r & 127); }
    if (n < 4096) return n;
    if (n < 7168) return n + 80;
    if (n < 7232) return n - 7168 + 4096;
    if (n < 7248) return n - 7232 + 4160;
    return -1;
}
DI void transpose_item(const float* src, int ld_src, int sc, bf16_t* dst, int ldd, int k0, int n0, LAS float* scr, int lane, const float* gk, float wscale) {
    const int kr = lane >> 3, n4 = (lane & 7) * 4;
    f32x4 v[8];
#pragma unroll
    for (int i = 0; i < 8; ++i) v[i] = (sc >= 0) ? *(const f32x4*)(src + (size_t)(k0 + 8 * i + kr) * ld_src + sc) : (f32x4){0.f, 0.f, 0.f, 0.f};
    if (gk) {
#pragma unroll
        for (int i = 0; i < 8; ++i) v[i] = v[i] * gk[k0 + 8 * i + kr]; }
    if (wscale != 1.0f) {
#pragma unroll
        for (int i = 0; i < 8; ++i) v[i] = v[i] * wscale; }
#pragma unroll
    for (int i = 0; i < 8; ++i) { LAS float* w = scr + (8 * i + kr) * 33 + n4; w[0] = v[i].x; w[1] = v[i].y; w[2] = v[i].z; w[3] = v[i].w; }
    LDS_WAIT(); asm volatile("" ::: "memory");
    const int cc = lane & 7;
#pragma unroll
    for (int j = 0; j < 4; ++j) { const int n = (lane >> 3) + 8 * j; const LAS float* s = scr + (8 * cc) * 33 + n;
        u32x4 o; o.x = pk2(s[0 * 33], s[1 * 33]); o.y = pk2(s[2 * 33], s[3 * 33]); o.z = pk2(s[4 * 33], s[5 * 33]); o.w = pk2(s[6 * 33], s[7 * 33]);
        *(u32x4*)(dst + (size_t)(n0 + n) * ldd + k0 + 8 * cc) = o; }
    LDS_WAIT(); asm volatile("" ::: "memory");
}
template <class KP> DI void phase_convert(const Ctx& c, KP ka, unsigned char* ws) {
    TID_LANE();
    LAS float* scr = (LAS float*)(c.lds + c.wave * 8448);
    for (int jj = 0; jj < 26; ++jj) { const int job = 25 - jj;
        const float* src; const float* gk = nullptr; float wscale = 1.0f; int ld_src, K, ldd, Ndst, koff = 0, map = 0; bf16_t* dst;
        if (job < 8)       { src = as_global(ka->in[2]) + (size_t)job * D * FF2; gk = as_global(ka->in[1]) + (size_t)((job >> 1) * 3 + (job & 1) * 2) * D; ld_src = FF2; K = D; Ndst = FF2; ldd = D; map = 1; dst = (bf16_t*)(ws + WS_WGU) + (size_t)job * FF2 * D; }
        else if (job < 16) { const int j = job - 8; wscale = 0.5f; src = as_global(ka->in[3]) + (size_t)j * FF * D;   ld_src = D; K = FF; Ndst = D; ldd = FF; dst = (bf16_t*)(ws + WS_WDN) + (size_t)j * D * FF; }
        else if (job < 18) { const int j = job - 16; src = as_global(ka->in[4]) + (size_t)j * D * ABIN; gk = as_global(ka->in[1]) + (size_t)((2 * j) * 3 + 1) * D; ld_src = ABIN; K = D; Ndst = ABIN; ldd = D; dst = (bf16_t*)(ws + WS_WABIN) + (size_t)j * ABIN * D; }
        else if (job < 20) { const int j = job - 18; src = as_global(ka->in[9]) + (size_t)j * D * CDIN; gk = as_global(ka->in[1]) + (size_t)((2 * j + 1) * 3 + 1) * D; ld_src = CDIN; K = D; Ndst = LDP; ldd = D; map = 2; dst = (bf16_t*)(ws + WS_WCDIN) + (size_t)j * LDP * D; }
        else if (job < 22) { const int j = job - 20; src = as_global(ka->in[8]) + (size_t)j * D * D; ld_src = D; K = 1024; Ndst = D; ldd = D; dst = (bf16_t*)(ws + WS_WABOUT) + (size_t)j * D * D; }
        else if (job < 24) { const int j = job - 22; src = (const float*)(ws + WS_WP) + (size_t)j * 1024 * D; ld_src = D; K = 1024; Ndst = D; ldd = D; koff = 1024; dst = (bf16_t*)(ws + WS_WABOUT) + (size_t)j * D * D; }
        else               { const int j = job - 24; src = as_global(ka->in[11]) + (size_t)j * D * D; ld_src = D; K = D; Ndst = D; ldd = D; dst = (bf16_t*)(ws + WS_WCDOUT) + (size_t)j * D * D; }
        const int nblk = Ndst / 32, nitems = (K / 64) * nblk;
        int w = c.gw + job * 797; w %= c.NGW;
        for (int it = w; it < nitems; it += c.NGW) {
            const int kb = it / nblk, nb = it - kb * nblk;
            const int sc = map_col(map, nb * 32 + (lane_ & 7) * 4);
            transpose_item(src, ld_src, sc, dst + koff, ldd, kb * 64, nb * 32, scr, lane_, gk, wscale);
        }
    }
}

DI void unpack8(const u32x4 w, float (&f)[8]) { f[0] = bflo(w.x); f[1] = bfhi(w.x); f[2] = bflo(w.y); f[3] = bfhi(w.y); f[4] = bflo(w.z); f[5] = bfhi(w.z); f[6] = bflo(w.w); f[7] = bfhi(w.w); }
DI u32x4 pack8(const float (&f)[8]) { u32x4 w; w.x = pk2(f[0], f[1]); w.y = pk2(f[2], f[3]); w.z = pk2(f[4], f[5]); w.w = pk2(f[6], f[7]); return w; }
DI void phase_first(const Ctx& c, const float* src, bf16_t* HBp, float* rstd) {
    TID_LANE();
    for (int m = c.gw; m < M; m += c.NGW) {
        const f32x4* xr = (const f32x4*)(src + (size_t)m * D) + lane_; f32x4 v[8]; float s = 0.f;
#pragma unroll
        for (int j = 0; j < 8; ++j) { v[j] = xr[64 * j]; s += (v[j].x * v[j].x + v[j].y * v[j].y) + (v[j].z * v[j].z + v[j].w * v[j].w); }
        s = wave_sum(s, lane_);
        if (lane_ == 0) rstd[m] = 1.0f / sqrtf(s * (1.0f / D) + 1e-6f);
        u32x2* o = (u32x2*)(HBp + (size_t)m * D) + lane_;
#pragma unroll
        for (int j = 0; j < 8; ++j) { u32x2 w; w.x = pk2(v[j].x, v[j].y); w.y = pk2(v[j].z, v[j].w); o[64 * j] = w; }
    }
}
DI void phase_rstd(const Ctx& c, const float* ssq, float* rstd) {
    const int gtid = c.bid * NTHREADS + opaque(threadIdx.x), NT_ = c.G * NTHREADS;
    for (int row = gtid; row < M; row += NT_) { const f32x4* p = (const f32x4*)(ssq + (size_t)row * 32); float s = 0.f;
#pragma unroll
        for (int k = 0; k < 8; ++k) { const f32x4 v = p[k]; s += (v.x + v.y) + (v.z + v.w); }
        rstd[row] = 1.0f / sqrtf(s * (1.0f / D) + 1e-6f); }
}
DI void phase_final_norm(const Ctx& c, const bf16_t* HBp, const float* gain, float* outp) {
    TID_LANE();
    for (int m = c.gw; m < M; m += c.NGW) {
        const u32x4* hr = (const u32x4*)(HBp + (size_t)m * D) + lane_; float h[4][8]; float s = 0.f;
#pragma unroll
        for (int j = 0; j < 4; ++j) { unpack8(hr[64 * j], h[j]);
#pragma unroll
            for (int k = 0; k < 8; ++k) s += h[j][k] * h[j][k]; }
        const float rstd = 1.0f / sqrtf(wave_sum(s, lane_) * (1.0f / D) + 1e-6f);
#pragma unroll
        for (int j = 0; j < 4; ++j) { const int col = (lane_ + 64 * j) * 8; const f32x4 g0 = *(const f32x4*)(gain + col), g1 = *(const f32x4*)(gain + col + 4);
            f32x4 o0 = {h[j][0] * rstd * g0.x, h[j][1] * rstd * g0.y, h[j][2] * rstd * g0.z, h[j][3] * rstd * g0.w}, o1 = {h[j][4] * rstd * g1.x, h[j][5] * rstd * g1.y, h[j][6] * rstd * g1.z, h[j][7] * rstd * g1.w};
            *(f32x4*)(outp + (size_t)m * D + col) = o0; *(f32x4*)(outp + (size_t)m * D + col + 4) = o1; }
    }
}

DI void phase_convpool(const Ctx& c, const bf16_t* PROJ, const float* conv_w, bf16_t* YC) {
    TID_LANE();
    const int half = lane_ >> 5, l32 = lane_ & 31;
    for (int task = c.gw; task < 4096; task += c.NGW) {
        const int ob = task & 7, rp = task >> 3;
        const int t0 = (rp * 2 + half) * 32, tpos0 = t0 & (T - 1);
        const int oct = ob * 32 + l32;
        if (ob < 4) {
            const int ch = oct * 8;
            float w0[8], w1[8], w2[8], up1[8], up2[8];
#pragma unroll
            for (int i = 0; i < 8; ++i) { w0[i] = conv_w[ch + i]; w1[i] = conv_w[1024 + ch + i]; w2[i] = conv_w[2048 + ch + i]; up1[i] = 0.f; up2[i] = 0.f; }
            if (tpos0 != 0) {
                float a[8], b[8];
                const bf16_t* r2 = PROJ + (size_t)(t0 - 2) * ABIN + ch; const bf16_t* r1 = r2 + ABIN;
                unpack8(*(const u32x4*)(r2 + 1024), a); unpack8(*(const u32x4*)(r2 + 2048), b);
#pragma unroll
                for (int i = 0; i < 8; ++i) up2[i] = a[i] * b[i];
                unpack8(*(const u32x4*)(r1 + 1024), a); unpack8(*(const u32x4*)(r1 + 2048), b);
#pragma unroll
                for (int i = 0; i < 8; ++i) up1[i] = a[i] * b[i];
            }
            for (int i = 0; i < 32; ++i) {
                const bf16_t* r = PROJ + (size_t)(t0 + i) * ABIN + ch;
                float bb[8], cc[8], hh[8], y[8];
                unpack8(*(const u32x4*)r, bb); unpack8(*(const u32x4*)(r + 1024), cc); unpack8(*(const u32x4*)(r + 2048), hh);
#pragma unroll
                for (int k = 0; k < 8; ++k) { const float u = cc[k] * hh[k]; y[k] = bb[k] * (w0[k] * up2[k] + w1[k] * up1[k] + w2[k] * u); up2[k] = up1[k]; up1[k] = u; }
                *(u32x4*)(YC + (size_t)(t0 + i) * D + ch) = pack8(y);
            }
        } else {
            const int g = ob - 4, w = 2 << g, ch = (oct - 128) * 8;
            const bf16_t* base = PROJ + 3072 + ch;
            float S[8];
#pragma unroll
            for (int k = 0; k < 8; ++k) S[k] = 0.f;
            if (tpos0 != 0) for (int s = t0 - w + 1; s < t0; ++s) { float x[8]; unpack8(*(const u32x4*)(base + (size_t)s * ABIN), x);
#pragma unroll
                for (int k = 0; k < 8; ++k) S[k] += x[k]; }
            for (int i = 0; i < 32; ++i) {
                const int row = t0 + i, tp = tpos0 + i;
                float x[8], y[8]; unpack8(*(const u32x4*)(base + (size_t)row * ABIN), x);
                const int cnt = (tp + 1) < w ? (tp + 1) : w; const float rc = 1.0f / (float)cnt;
#pragma unroll
                for (int k = 0; k < 8; ++k) { S[k] += x[k]; y[k] = S[k] * rc - x[k]; }
                *(u32x4*)(YC + (size_t)row * D + 1024 + ch) = pack8(y);
                if (tp - w + 1 >= 0) { float z[8]; unpack8(*(const u32x4*)(base + (size_t)(row - w + 1) * ABIN), z);
#pragma unroll
                    for (int k = 0; k < 8; ++k) S[k] -= z[k]; }
            }
        }
    }
}

constexpr int IXP = 72;
typedef _Float16 h2v __attribute__((ext_vector_type(2)));
typedef unsigned short us2v __attribute__((ext_vector_type(2)));
typedef short ss2v __attribute__((ext_vector_type(2)));
DI void indexer_wg(const Ctx& c, const bf16_t* PROJ, const bf16_t* IKWb, unsigned* SC, int b, int tg) {
    const int tid = opaque(threadIdx.x), lane = tid & 63, r32 = lane & 31, hi = lane >> 5, tl = r32 >> 4, h = r32 & 15;
    const int t0w = tg * 32 + c.wave * 4;
    const size_t rowbase = (size_t)b * T + t0w;
    bf16x8 A[2][4]; float w[2][2][8];
#pragma unroll
    for (int u = 0; u < 2; ++u)
#pragma unroll
        for (int ks = 0; ks < 4; ++ks) A[u][ks] = *(const bf16x8*)(PROJ + (rowbase + 2 * u + tl) * LDP + IQ + h * 64 + ks * 16 + hi * 8);
#pragma unroll
    for (int u = 0; u < 2; ++u)
#pragma unroll
        for (int t2 = 0; t2 < 2; ++t2)
#pragma unroll
            for (int i = 0; i < 8; ++i) w[u][t2][i] = (0.5f * 0.03125f) * bf1(IKWb[(rowbase + 2 * u + t2) * 256 + 64 + (i >> 2) * 8 + 4 * hi + (i & 3)]);
    const int vis_end = (((tg * 32) >> 6) + 1) << 6, nsteps = (vis_end + 255) >> 8;
    LAS bf16_t* buf = (LAS bf16_t*)c.lds;
    const bf16_t* kg = IKWb + (size_t)b * T * 256;
    u32x4 st[4];
#define IX_LOAD(s0) do { _Pragma("unroll") for (int k = 0; k < 4; ++k) { const int cc = tid + 512 * k, key = cc >> 3, part = cc & 7; \
        const int kk = ((s0) + key < vis_end) ? (s0) + key : vis_end - 1; st[k] = *(const u32x4*)(kg + (size_t)kk * 256 + part * 8); } } while (0)
#define IX_WRITE(bb) do { _Pragma("unroll") for (int k = 0; k < 4; ++k) { const int cc = tid + 512 * k, key = cc >> 3, part = cc & 7; \
        *(LAS u32x4*)(buf + (bb) * 256 * IXP + key * IXP + part * 8) = st[k]; } } while (0)
    __syncthreads();
    IX_LOAD(0); IX_WRITE(0); __syncthreads();
    for (int sp = 0; sp < nsteps; ++sp) {
        const int s0 = sp * 256, cur = sp & 1;
        if (sp + 1 < nsteps) IX_LOAD(s0 + 256);
        const int ngrp = (vis_end - s0) >= 256 ? 2 : ((vis_end - s0 + 127) >> 7);
        const LAS bf16_t* bb = buf + cur * 256 * IXP + r32 * IXP + hi * 8;
        for (int gt = 0; gt < 2 * ngrp; ++gt) {
            const int g = gt >> 1, tt = gt & 1;
            float sc[2][2];
            bf16x8 Bc[2][4];
#pragma unroll
            for (int pp = 0; pp < 2; ++pp)
#pragma unroll
                for (int ks = 0; ks < 4; ++ks) Bc[pp][ks] = *(const LAS bf16x8*)(bb + (4 * g + tt + 2 * pp) * 32 * IXP + ks * 16);
#define IX_CHAIN(acc, u, pp) do { _Pragma("unroll") for (int r = 0; r < 16; ++r) acc[r] = 0.f; _Pragma("unroll") for (int ks = 0; ks < 4; ++ks) acc = MFMA32(A[u][ks], Bc[pp][ks], acc); } while (0)
#define IX_VALU(acc, u, pp) do { float p0 = 0.f, p1 = 0.f; _Pragma("unroll") for (int r = 0; r < 8; ++r) { p0 = fmaf(fabsf(acc[r]), w[u][0][r], fmaf(acc[r], w[u][0][r], p0)); p1 = fmaf(fabsf(acc[8 + r]), w[u][1][r], fmaf(acc[8 + r], w[u][1][r], p1)); } \
        auto rr = __builtin_amdgcn_permlane32_swap(__float_as_uint(p0), __float_as_uint(p1), false, false); sc[u][pp] = __uint_as_float(rr[0]) + __uint_as_float(rr[1]); } while (0)
            f32x16 a0, a1, a2, a3;
            IX_CHAIN(a0, 0, 0); IX_CHAIN(a1, 1, 0); asm volatile("" : "+v"(a0), "+v"(a1));
            IX_CHAIN(a2, 0, 1); asm volatile("" : "+v"(a2)); IX_VALU(a0, 0, 0);
            IX_CHAIN(a3, 1, 1); asm volatile("" : "+v"(a3)); IX_VALU(a1, 1, 0);
            IX_VALU(a2, 0, 1); IX_VALU(a3, 1, 1);
#undef IX_CHAIN
#undef IX_VALU
#pragma unroll
            for (int u = 0; u < 2; ++u) { const h2v hv = {(_Float16)sc[u][0], (_Float16)sc[u][1]};
                SC[(rowbase + 2 * u + hi) * 2048 + (2 * sp + g) * 64 + tt * 32 + r32] = __builtin_bit_cast(unsigned, hv); }
        }
        if (sp + 1 < nsteps) IX_WRITE(cur ^ 1);
        __syncthreads();
    }
#undef IX_LOAD
#undef IX_WRITE
}

DI int wave_sum_i(int x) {
    x += __builtin_amdgcn_update_dpp(0, x, 0xB1, 0xf, 0xf, true);
    x += __builtin_amdgcn_update_dpp(0, x, 0x4E, 0xf, 0xf, true);
    x += __builtin_amdgcn_update_dpp(0, x, 0x141, 0xf, 0xf, true);
    x += __builtin_amdgcn_update_dpp(0, x, 0x140, 0xf, 0xf, true);
    return __builtin_amdgcn_readlane(x, 0) + __builtin_amdgcn_readlane(x, 16) + __builtin_amdgcn_readlane(x, 32) + __builtin_amdgcn_readlane(x, 48);
}
DI void cnt_gt4_pk(unsigned& a0, unsigned& a1, unsigned& a2, unsigned& a3, unsigned k0, unsigned k1, unsigned k2, unsigned k3, unsigned cc, unsigned one) {
    unsigned d0, d1, d2, d3;
    asm volatile("v_pk_sub_u16 %4, %8, %12 clamp\n\tv_pk_sub_u16 %5, %9, %12 clamp\n\tv_pk_sub_u16 %6, %10, %12 clamp\n\tv_pk_sub_u16 %7, %11, %12 clamp\n\t"
                 "v_pk_min_u16 %4, %4, %13\n\tv_pk_min_u16 %5, %5, %13\n\tv_pk_min_u16 %6, %6, %13\n\tv_pk_min_u16 %7, %7, %13\n\t"
                 "v_pk_add_u16 %0, %0, %4\n\tv_pk_add_u16 %1, %1, %5\n\tv_pk_add_u16 %2, %2, %6\n\tv_pk_add_u16 %3, %3, %7"
                 : "+v"(a0), "+v"(a1), "+v"(a2), "+v"(a3), "=&v"(d0), "=&v"(d1), "=&v"(d2), "=&v"(d3)
                 : "v"(k0), "v"(k1), "v"(k2), "v"(k3), "s"(cc), "v"(one));
}
template <int W> DI void emit4(int& mlo, int& mhi, int k0, int k1, int k2, int k3, int thr) {
    asm volatile("v_cmp_gt_i32_e64 s[88:89], %2, %6\n\tv_cmp_gt_i32_e64 s[90:91], %3, %6\n\tv_cmp_gt_i32_e64 s[92:93], %4, %6\n\tv_cmp_gt_i32_e64 s[94:95], %5, %6\n\ts_nop 1\n\t"
                 "v_writelane_b32 %0, s88, %7\n\tv_writelane_b32 %1, s89, %7\n\tv_writelane_b32 %0, s90, %8\n\tv_writelane_b32 %1, s91, %8\n\t"
                 "v_writelane_b32 %0, s92, %9\n\tv_writelane_b32 %1, s93, %9\n\tv_writelane_b32 %0, s94, %10\n\tv_writelane_b32 %1, s95, %10"
                 : "+v"(mlo), "+v"(mhi)
                 : "v"(k0), "v"(k1), "v"(k2), "v"(k3), "s"(thr), "n"(W), "n"(W + 1), "n"(W + 2), "n"(W + 3)
                 : "s88", "s89", "s90", "s91", "s92", "s93", "s94", "s95");
}
DI void phase_select(const Ctx& c, const unsigned* SC, unsigned long long* BM) {
    const int lane = opaque(threadIdx.x) & 63;
    unsigned nx[32]; unsigned one2 = 0x00010001u; asm volatile("" : "+v"(one2));
#define SEL_LOAD(row) do { const int np_ = (((((row) & (T - 1)) >> 6) + 1) + 1) >> 1; const unsigned* sr_ = SC + (size_t)(row) * 2048 + lane; \
        _Pragma("unroll") for (int j = 0; j < 32; ++j) nx[j] = sr_[64 * (j < np_ ? j : np_ - 1)]; } while (0)
    int row = c.gw;
    if (row < M) SEL_LOAD(row);
    for (; row < M; row += c.NGW) {
        const int t = row & (T - 1), nw = (t >> 6) + 1;
        unsigned key[32];
#pragma unroll
        for (int j = 0; j < 32; ++j) { const unsigned x = nx[j]; const ss2v sg = __builtin_bit_cast(ss2v, x) >> 15;
            const unsigned k = x ^ (__builtin_bit_cast(unsigned, sg) | 0x80008000u);
            const unsigned vm = ((2 * j < nw) ? 0xffffu : 0u) | ((2 * j + 1 < nw) ? 0xffff0000u : 0u); key[j] = k & vm; }
        if (row + c.NGW < M) SEL_LOAD(row + c.NGW);
        unsigned long long* bmr = BM + (size_t)row * 64;
        if (nw <= 4) { bmr[lane] = (lane < nw) ? ~0ull : 0ull; continue; }
        int prefix = 0, thr = 0; bool exact = false;
        for (int bit = 15; bit >= 0; --bit) {
            const int cand = prefix | (1 << bit), cm1 = cand - 1; const unsigned cc = (unsigned)__builtin_amdgcn_readfirstlane(cm1 * 0x10001);
            unsigned a0 = 0, a1 = 0, a2 = 0, a3 = 0;
#pragma unroll
            for (int j = 0; j < 32; j += 4) cnt_gt4_pk(a0, a1, a2, a3, key[j], key[j + 1], key[j + 2], key[j + 3], cc, one2);
            const unsigned as = (a0 + a1) + (a2 + a3);
            const int cnt = wave_sum_i((int)(as & 0xffffu) + (int)(as >> 16));
            if (cnt >= 256) prefix = cand;
            if (cnt == 256) { exact = true; thr = cm1; break; }
        }
        int need = 0;
        if (!exact) { thr = prefix; const unsigned cc = (unsigned)__builtin_amdgcn_readfirstlane(thr * 0x10001); unsigned a0 = 0, a1 = 0, a2 = 0, a3 = 0;
#pragma unroll
            for (int j = 0; j < 32; j += 4) cnt_gt4_pk(a0, a1, a2, a3, key[j], key[j + 1], key[j + 2], key[j + 3], cc, one2);
            const unsigned as = (a0 + a1) + (a2 + a3);
            need = 256 - wave_sum_i((int)(as & 0xffffu) + (int)(as >> 16)); }
        int mlo = 0, mhi = 0;
        { const int thr_s = __builtin_amdgcn_readfirstlane(thr);
#define EM4(W) emit4<W>(mlo, mhi, (int)(key[(W) / 2] & 0xffffu), (int)(key[(W) / 2] >> 16), (int)(key[(W) / 2 + 1] & 0xffffu), (int)(key[(W) / 2 + 1] >> 16), thr_s)
          EM4(0); EM4(4); EM4(8); EM4(12); EM4(16); EM4(20); EM4(24); EM4(28); EM4(32); EM4(36); EM4(40); EM4(44); EM4(48); EM4(52); EM4(56); EM4(60);
#undef EM4
        }
        if (need > 0) {
#pragma unroll
            for (int j = 0; j < 32; ++j) {
#pragma unroll
                for (int hh = 0; hh < 2; ++hh) { const int kk = hh ? (int)(key[j] >> 16) : (int)(key[j] & 0xffffu);
                    if (need > 0) { unsigned long long e = __ballot(kk == thr);
                        if (e) { int pc = __popcll(e); while (pc > need) { e &= ~(1ull << (63 - __clzll(e))); --pc; } need -= pc;
                            const unsigned long long m = __ballot(kk > thr) | e;
                            mlo = (lane == 2 * j + hh) ? (int)(unsigned)m : mlo; mhi = (lane == 2 * j + hh) ? (int)(unsigned)(m >> 32) : mhi; } } }
            }
        }
        const unsigned long long mine = ((unsigned long long)(unsigned)mhi << 32) | (unsigned)mlo;
        bmr[lane] = mine;
    }
#undef SEL_LOAD
}

namespace att {
constexpr float SCALE = 0.08838834764831845f, THR = 8.f, NEGM = -3.0e30f;
constexpr int SHM_V = 16384, SHM_K = 16384, OFF_V = 0, OFF_K = 32768, OFF_WS = 65536, OFF_LUT = 65536 + 2048, LDS_NEED = OFF_LUT + 2048;
#define KSWZ(row, colB) ((row) * 256 + ((colB) ^ (((row) & 7) << 4)))
DI void partialSM(f32x16& p0, f32x16& p1, float& m_reg, float& mn, float& alpha) {
    constexpr float C = SCALE * 1.4426950408889634f;
    float pmax = p0[0];
#pragma unroll
    for (int r = 1; r < 16; ++r) pmax = fmaxf(pmax, p0[r]);
#pragma unroll
    for (int r = 0; r < 16; ++r) pmax = fmaxf(pmax, p1[r]);
    { auto rr = __builtin_amdgcn_permlane32_swap(__float_as_uint(pmax), __float_as_uint(pmax), false, false);
      pmax = fmaxf(__uint_as_float(rr[0]), __uint_as_float(rr[1])); }
    if (__builtin_expect(__all(pmax - m_reg <= THR / SCALE), 1)) { mn = m_reg; alpha = 1.f; }
    else { mn = fmaxf(m_reg, pmax); alpha = fast_exp2((m_reg - mn) * C); m_reg = mn; }
    const float mnC = -mn * C;
#pragma unroll
    for (int r = 0; r < 16; ++r) p0[r] = fmaf(p0[r], C, mnC);
#pragma unroll
    for (int r = 0; r < 16; ++r) p1[r] = fmaf(p1[r], C, mnC);
#pragma unroll
    for (int r = 0; r < 16; ++r) p0[r] = fast_exp2(p0[r]);
}
DI void finishSM(f32x16& p0, f32x16& p1, float alpha, float& l_reg, bf16x8& pa0, bf16x8& pa1, bf16x8& pa2, bf16x8& pa3) {
#pragma unroll
    for (int r = 0; r < 16; ++r) p1[r] = fast_exp2(p1[r]);
    float ps = 0;
#pragma unroll
    for (int r = 0; r < 16; ++r) ps += p0[r];
#pragma unroll
    for (int r = 0; r < 16; ++r) ps += p1[r];
    { auto rr = __builtin_amdgcn_permlane32_swap(__float_as_uint(ps), __float_as_uint(ps), false, false);
      ps = __uint_as_float(rr[0]) + __uint_as_float(rr[1]); }
    l_reg = l_reg * alpha + ps;
#define PK4(P, BASE, OUT) do { unsigned a0 = pk2(P[BASE + 0], P[BASE + 1]), a1 = pk2(P[BASE + 2], P[BASE + 3]);   \
    unsigned b0 = pk2(P[BASE + 4], P[BASE + 5]), b1 = pk2(P[BASE + 6], P[BASE + 7]);                              \
    auto r0 = __builtin_amdgcn_permlane32_swap(a0, b0, false, false); auto r1 = __builtin_amdgcn_permlane32_swap(a1, b1, false, false); \
    u32x4 w = {r0[0], r1[0], r0[1], r1[1]}; OUT = __builtin_bit_cast(bf16x8, w); } while (0)
    PK4(p0, 0, pa0); PK4(p0, 8, pa1); PK4(p1, 0, pa2); PK4(p1, 8, pa3);
#undef PK4
}
DI bf16x8 lds_read128(unsigned addr) { bf16x8 r; asm volatile("ds_read_b128 %0, %1" : "=&v"(r) : "v"(addr) : "memory"); return r; }
DI void qkt(f32x16& p0, f32x16& p1, unsigned ks_addr  , const bf16x8* qr, int r32, int hi) {
    bf16x8 a0, a1, b0, b1;
#define QK_RD(d0, x0, x1) do { const int cb_ = ((d0) * 16 + hi * 8) * 2; x0 = lds_read128(ks_addr + (unsigned)KSWZ(r32, cb_)); x1 = lds_read128(ks_addr + (unsigned)KSWZ(32 + r32, cb_)); } while (0)
#define QK_MM(d0, x0, x1) do { p0 = MFMA32(x0, qr[d0], p0); p1 = MFMA32(x1, qr[d0], p1); } while (0)
    QK_RD(0, a0, a1);
    QK_RD(1, b0, b1); asm volatile("s_waitcnt lgkmcnt(2)" ::: "memory"); SBAR(); QK_MM(0, a0, a1); SBAR();
    QK_RD(2, a0, a1); asm volatile("s_waitcnt lgkmcnt(2)" ::: "memory"); SBAR(); QK_MM(1, b0, b1); SBAR();
    QK_RD(3, b0, b1); asm volatile("s_waitcnt lgkmcnt(2)" ::: "memory"); SBAR(); QK_MM(2, a0, a1); SBAR();
    QK_RD(4, a0, a1); asm volatile("s_waitcnt lgkmcnt(2)" ::: "memory"); SBAR(); QK_MM(3, b0, b1); SBAR();
    QK_RD(5, b0, b1); asm volatile("s_waitcnt lgkmcnt(2)" ::: "memory"); SBAR(); QK_MM(4, a0, a1); SBAR();
    QK_RD(6, a0, a1); asm volatile("s_waitcnt lgkmcnt(2)" ::: "memory"); SBAR(); QK_MM(5, b0, b1); SBAR();
    QK_RD(7, b0, b1); asm volatile("s_waitcnt lgkmcnt(2)" ::: "memory"); SBAR(); QK_MM(6, a0, a1); SBAR();
    asm volatile("s_waitcnt lgkmcnt(0)" ::: "memory"); SBAR(); QK_MM(7, b0, b1);
#undef QK_RD
#undef QK_MM
}
DI int v_st(int k, int c) { const int kk = (k & ~0xC) | ((k & 4) << 1) | ((k & 8) >> 1); return ((kk >> 3) * 4 + (c >> 5)) * 512 + ((kk & 7) * 32 + (c & 31)) * 2; }
DI int v_rd_base(int lane) { return ((lane & 3) << 3) | (((lane >> 2) & 3) << 6) | (((lane >> 4) & 1) << 5) | (((lane >> 5) & 1) << 8); }
constexpr int v_rd_off(int d0, int ks, int half) { return d0 * 512 + ks * 4096 + half * 2048; }
template <int OFF> DI s16x4 tr_read_o(int vb) { s16x4 r; asm volatile("ds_read_b64_tr_b16 %0, %1 offset:%2" : "=&v"(r) : "v"(vb), "i"(OFF) : "memory"); return r; }
template <int KS> DI void pv_reads(int vb, s16x4 (&l)[4], s16x4 (&h)[4]) {
    l[0] = tr_read_o<v_rd_off(0, KS, 0)>(vb); h[0] = tr_read_o<v_rd_off(0, KS, 1)>(vb); l[1] = tr_read_o<v_rd_off(1, KS, 0)>(vb); h[1] = tr_read_o<v_rd_off(1, KS, 1)>(vb);
    l[2] = tr_read_o<v_rd_off(2, KS, 0)>(vb); h[2] = tr_read_o<v_rd_off(2, KS, 1)>(vb); l[3] = tr_read_o<v_rd_off(3, KS, 0)>(vb); h[3] = tr_read_o<v_rd_off(3, KS, 1)>(vb);
}
DI void pv_mma(f32x16* o, bf16x8 pa, const s16x4 (&l)[4], const s16x4 (&h)[4]) {
    o[0] = MFMA32(pa, CAT8(l[0], h[0]), o[0]); o[1] = MFMA32(pa, CAT8(l[1], h[1]), o[1]); o[2] = MFMA32(pa, CAT8(l[2], h[2]), o[2]); o[3] = MFMA32(pa, CAT8(l[3], h[3]), o[3]);
}
DI void pv_d0(f32x16* o, int vb, bf16x8 pa0, bf16x8 pa1, bf16x8 pa2, bf16x8 pa3) {
    s16x4 la[4], ha[4], lb[4], hb[4];
    pv_reads<0>(vb, la, ha);
    pv_reads<1>(vb, lb, hb);
    asm volatile("s_waitcnt lgkmcnt(8)" ::: "memory"); SBAR(); pv_mma(o, pa0, la, ha); SBAR();
    pv_reads<2>(vb, la, ha);
    asm volatile("s_waitcnt lgkmcnt(8)" ::: "memory"); SBAR(); pv_mma(o, pa1, lb, hb); SBAR();
    pv_reads<3>(vb, lb, hb);
    asm volatile("s_waitcnt lgkmcnt(8)" ::: "memory"); SBAR(); pv_mma(o, pa2, la, ha); SBAR();
    asm volatile("s_waitcnt lgkmcnt(0)" ::: "memory"); SBAR(); pv_mma(o, pa3, lb, hb);
}
DI float sel_bits(unsigned w, int bit, float yes, float no) {
    const int m = __builtin_amdgcn_sbfe(w, bit, 1); float r;
    asm("v_bfi_b32 %0, %1, %2, %3" : "=v"(r) : "v"(m), "v"(yes), "v"(no));
    return r;
}
DI void mask_bias_init(f32x16& p0, f32x16& p1, unsigned long long mw, int j, int tpos, int hi, bool farj, float cb15, const LAS float* lut) {
    const unsigned lo = (unsigned)mw >> (4 * hi), hw = (unsigned)(mw >> 32) >> (4 * hi);
    if (farj) {
#pragma unroll
        for (int r = 0; r < 16; ++r) { const int cr = (r & 3) + 8 * (r >> 2);
            p0[r] = sel_bits(lo, cr, cb15, NEGM); p1[r] = sel_bits(hw, cr, cb15, NEGM); }
    } else {
        const LAS float* lp = lut + (64 * j - tpos + 256 + 4 * hi);
#pragma unroll
        for (int r = 0; r < 16; ++r) { const int cr = (r & 3) + 8 * (r >> 2); p0[r] = lp[cr]; p1[r] = lp[32 + cr]; }
        SBAR();
#pragma unroll
        for (int r = 0; r < 16; ++r) { const int cr = (r & 3) + 8 * (r >> 2);
            p0[r] = sel_bits(lo, cr, p0[r], NEGM); p1[r] = sel_bits(hw, cr, p1[r], NEGM); }
    }
}
DI void attn_unit(const Ctx& c, const bf16_t* Qb, const bf16_t* Kh, const bf16_t* Vh, bf16_t* Ob, const unsigned long long* bm, int q0, int NT, int h, const float* bias_table) {
    const int tid = opaque(threadIdx.x), wid = c.wave, lane = tid & 63, r32 = lane & 31, hi = lane >> 5;
    LAS char* lds = (LAS char*)c.lds;
    LAS char* V_lds = lds + OFF_V; LAS char* K_lds = lds + OFF_K;
    LAS float* wsf = (LAS float*)(lds + OFF_WS) + wid * 64; LAS float* li_l = wsf; LAS float* al_l = wsf + 32;
    LAS float* lut = (LAS float*)(lds + OFF_LUT);
    __syncthreads();
    { const int rel = tid - 256, n = rel < 0 ? -rel : rel;
      const int lg = n < 8 ? n : (n < 12 ? 8 : n < 16 ? 9 : n < 23 ? 10 : n < 32 ? 11 : n < 46 ? 12 : n < 64 ? 13 : n < 91 ? 14 : 15);
      lut[tid] = bias_table[((rel > 0 ? 16 : 0) + lg) * 8 + h] * 11.313708498984761f; }
    float m_reg = -1e30f, l_reg = 0; f32x16 o[4]; bf16x8 qr[8];
#pragma unroll
    for (int d = 0; d < 4; ++d)
#pragma unroll
        for (int r = 0; r < 16; ++r) o[d][r] = 0.f;
    const bf16_t* Qw = Qb + (size_t)(wid * 32 + r32) * LDP + hi * 8;
#pragma unroll
    for (int d0 = 0; d0 < 8; ++d0) qr[d0] = *(const bf16x8*)(Qw + d0 * 16);
    const int tpos = q0 + wid * 32 + r32;
    const unsigned long long* bmr = bm + (size_t)tpos * 64;
    const int sr = tid >> 4, sc = (tid & 15) * 8, vst0 = v_st(sr, sc), vst1 = v_st(32 + sr, sc);
    const int vb0 = (int)c.ldsbase + OFF_V + v_rd_base(lane);
    bf16x8 vs0, vs1, ks0, ks1;
#define SLOAD(k0) do { vs0 = *(const bf16x8*)(Vh + (size_t)((k0) + sr) * LDP + sc); vs1 = *(const bf16x8*)(Vh + (size_t)((k0) + 32 + sr) * LDP + sc); \
    ks0 = *(const bf16x8*)(Kh + (size_t)((k0) + sr) * LDP + sc); ks1 = *(const bf16x8*)(Kh + (size_t)((k0) + 32 + sr) * LDP + sc); } while (0)
#define SWRITE(b) do { *(LAS bf16x8*)(V_lds + (b) * SHM_V + vst0) = vs0; *(LAS bf16x8*)(V_lds + (b) * SHM_V + vst1) = vs1; const int kc = sc * 2; \
    *(LAS bf16x8*)(K_lds + (b) * SHM_K + KSWZ(sr, kc)) = ks0; *(LAS bf16x8*)(K_lds + (b) * SHM_K + KSWZ(32 + sr, kc)) = ks1; } while (0)
#define RESC(a) do { if (__any((a) < 1.f)) { if (hi == 0) al_l[r32] = (a); asm volatile("s_waitcnt lgkmcnt(0)" ::: "memory"); \
    _Pragma("unroll") for (int d = 0; d < 4; ++d) _Pragma("unroll") for (int r = 0; r < 16; ++r) o[d][r] *= al_l[crow(r, hi)]; } } while (0)
#define FARJ(j) ((64 * (j) + 154) <= (q0 + 32 * wid))
    f32x16 p0, p1; float mn, al; bf16x8 pa0, pa1, pa2, pa3;
    SLOAD(0);
    asm volatile("s_waitcnt vmcnt(0)" ::: "memory"); SWRITE(0); __syncthreads();
    const float cb15 = lut[0];
    unsigned long long mwn = bmr[0];
    for (int j = 0; j < NT; ++j) {
        const int bsel = j & 1;
        const unsigned long long mw = mwn;
        if (j + 1 < NT) { mwn = bmr[j + 1]; SLOAD((j + 1) * 64); }
        mask_bias_init(p0, p1, mw, j, tpos, hi, FARJ(j), cb15, lut);
        asm volatile("s_waitcnt lgkmcnt(0)" ::: "memory"); SBAR(); qkt(p0, p1, c.ldsbase + OFF_K + bsel * SHM_K, qr, r32, hi);
        partialSM(p0, p1, m_reg, mn, al);
        RESC(al);
        finishSM(p0, p1, al, l_reg, pa0, pa1, pa2, pa3); SBAR();
        pv_d0(o, vb0 + bsel * SHM_V, pa0, pa1, pa2, pa3);
        if (j + 1 < NT) { asm volatile("s_waitcnt vmcnt(0)" ::: "memory"); SWRITE(bsel ^ 1); }
        __syncthreads();
    }
    if (hi == 0) li_l[r32] = l_reg; asm volatile("s_waitcnt lgkmcnt(0)" ::: "memory");
    float rli[16];
#pragma unroll
    for (int r = 0; r < 16; ++r) rli[r] = __builtin_amdgcn_rcpf(li_l[crow(r, hi)]);
    bf16_t* Ow = Ob + (size_t)(wid * 32) * D;
#pragma unroll
    for (int r = 0; r < 16; ++r) { const int orow = crow(r, hi);
#pragma unroll
        for (int d0 = 0; d0 < 4; ++d0) Ow[(size_t)orow * D + d0 * 32 + r32] = (bf16_t)(pk2(o[d0][r] * rli[r], 0.f) & 0xffffu); }
#undef SLOAD
#undef SWRITE
#undef RESC
#undef FARJ
}
}

constexpr int RKP = 72, RVP = 136;
constexpr int R_OFF_Q = 0, R_OFF_K = 9216, R_OFF_V = 18432, R_OFF_S = 18432 + 17408, R_OFF_ST = R_OFF_S + 18432;
DI void stage_rope64(LAS bf16_t* img, const bf16_t* src, int tpos0, float mul, float l2g_dec, bool dec, int tid) {
    if (tid < 256) {
        const int j = tid >> 2, oc = tid & 3;
        float x1[8], x2[8], o1[8], o2[8];
        unpack8(*(const u32x4*)(src + (size_t)j * LDP + 8 * oc), x1); unpack8(*(const u32x4*)(src + (size_t)j * LDP + 32 + 8 * oc), x2);
        const float t = (float)(tpos0 + j);
        const float mm = dec ? mul * fast_exp2((float)(63 - j) * l2g_dec) : mul;
#pragma unroll
        for (int ii = 0; ii < 8; ++ii) { const int i = 8 * oc + ii;
            const float gh = ROPE_HI[i], gl = ROPE_LO[i];
            const float p = t * gh, e = fmaf(t, gh, -p); const float rev = (p - floorf(p)) + (e + t * gl);
            const float sn = __builtin_amdgcn_sinf(rev), cs = __builtin_amdgcn_cosf(rev);
            o1[ii] = (x1[ii] * cs - x2[ii] * sn) * mm; o2[ii] = (x1[ii] * sn + x2[ii] * cs) * mm; }
        *(LAS u32x4*)(img + j * RKP + 8 * oc) = pack8(o1); *(LAS u32x4*)(img + j * RKP + 32 + 8 * oc) = pack8(o2);
    }
}
DI void stage_v64(LAS bf16_t* img, const bf16_t* src, int tid) {
#pragma unroll
    for (int k = 0; k < 2; ++k) { const int cc = tid + 512 * k, j = cc >> 4, e8 = (cc & 15) * 8; *(LAS u32x4*)(img + j * RVP + e8) = *(const u32x4*)(src + (size_t)j * LDP + e8); }
}
DI void r1_unit(const Ctx& c, const bf16_t* PROJ, float* KVT, int unit) {
    const int b = unit >> 9, h = (unit >> 6) & 7, n = unit & 63;
    const size_t row0 = (size_t)b * T + n * 64;
    LAS bf16_t* Kimg = (LAS bf16_t*)(c.lds + R_OFF_K); LAS bf16_t* Vimg = (LAS bf16_t*)(c.lds + R_OFF_V);
    const int tid = opaque(threadIdx.x);
    __syncthreads();
    stage_rope64(Kimg, PROJ + row0 * LDP + RK + h * 64, n * 64, 0.125f, L2G[h], true, tid);
    stage_v64(Vimg, PROJ + row0 * LDP + RV + h * 128, tid);
    __syncthreads();
    const int lane = tid & 63, eb = c.wave >> 1, db = c.wave & 1, q = (lane >> 2) & 3, p = lane & 3, g1 = (lane >> 4) & 1, hi = lane >> 5, r32 = lane & 31;
    const unsigned aV = c.ldsbase + R_OFF_V + (unsigned)(((8 * hi + q) * RVP + 32 * eb + 16 * g1 + 4 * p) * 2);
    const unsigned aK = c.ldsbase + R_OFF_K + (unsigned)(((8 * hi + q) * RKP + 32 * db + 16 * g1 + 4 * p) * 2);
    s16x4 al[4], ah[4], bl[4], bh[4];
#pragma unroll
    for (int s = 0; s < 4; ++s) { al[s] = tr_read(aV + (unsigned)(16 * s * RVP * 2)); ah[s] = tr_read(aV + (unsigned)((16 * s + 4) * RVP * 2));
        bl[s] = tr_read(aK + (unsigned)(16 * s * RKP * 2)); bh[s] = tr_read(aK + (unsigned)((16 * s + 4) * RKP * 2)); }
    asm volatile("s_waitcnt lgkmcnt(0)" ::: "memory"); SBAR();
    f32x16 acc;
#pragma unroll
    for (int r = 0; r < 16; ++r) acc[r] = 0.f;
#pragma unroll
    for (int s = 0; s < 4; ++s) acc = MFMA32(CAT8(al[s], ah[s]), CAT8(bl[s], bh[s]), acc);
    float* o = KVT + (size_t)unit * 8192 + 32 * db + r32;
#pragma unroll
    for (int r = 0; r < 16; ++r) o[(32 * eb + crow(r, hi)) * 64] = acc[r];
}
DI void phase_scan(const Ctx& c, const float* KVT, bf16_t* ST) {
    const int gtid = c.bid * NTHREADS + opaque(threadIdx.x), NT_ = c.G * NTHREADS;
    for (int q = gtid; q < 64 * 2048; q += NT_) {
        const int bh = q >> 11, e4 = (q & 2047) * 4, h = bh & 7;
        const float cdec = fast_exp2(64.0f * L2G[h]);
        f32x4 S = {0.f, 0.f, 0.f, 0.f};
        const float* kp = KVT + (size_t)bh * 64 * 8192 + e4; bf16_t* sp = ST + (size_t)bh * 64 * 8192 + e4;
#pragma unroll 8
        for (int n = 0; n < 64; ++n) { u32x2 w; w.x = pk2(S.x, S.y); w.y = pk2(S.z, S.w); *(u32x2*)(sp + (size_t)n * 8192) = w;
            const f32x4 kv = *(const f32x4*)(kp + (size_t)n * 8192); S = S * cdec + kv; }
    }
}
DI void rope_write(LAS bf16_t* img, const u32x4 r1, const u32x4 r2, int t4, int tpos0, float mul) {
    const int j = t4 >> 2, oc = t4 & 3;
    float x1[8], x2[8], o1[8], o2[8];
    unpack8(r1, x1); unpack8(r2, x2);
    const float t = (float)(tpos0 + j);
#pragma unroll
    for (int ii = 0; ii < 8; ++ii) { const int i = 8 * oc + ii;
        const float gh = ROPE_HI[i], gl = ROPE_LO[i];
        const float p = t * gh, e = fmaf(t, gh, -p); const float rev = (p - floorf(p)) + (e + t * gl);
        const float sn = __builtin_amdgcn_sinf(rev), cs = __builtin_amdgcn_cosf(rev);
        o1[ii] = (x1[ii] * cs - x2[ii] * sn) * mul; o2[ii] = (x1[ii] * sn + x2[ii] * cs) * mul; }
    *(LAS u32x4*)(img + j * RKP + 8 * oc) = pack8(o1); *(LAS u32x4*)(img + j * RKP + 32 + 8 * oc) = pack8(o2);
}
DI void phase_r3(const Ctx& c, const bf16_t* PROJ, const bf16_t* ST, const float* gain, bf16_t* YC) {
    LAS bf16_t* Qimg = (LAS bf16_t*)(c.lds + R_OFF_Q); LAS bf16_t* Kimg = (LAS bf16_t*)(c.lds + R_OFF_K); LAS bf16_t* Vimg = (LAS bf16_t*)(c.lds + R_OFF_V); LAS bf16_t* Simg = (LAS bf16_t*)(c.lds + R_OFF_S);
    LAS f32x2* stat = (LAS f32x2*)(c.lds + R_OFF_ST);
    const int tid = opaque(threadIdx.x);
    const int lane = tid & 63, ib = c.wave & 1, eb = c.wave >> 1, q = (lane >> 2) & 3, p = lane & 3, g1 = (lane >> 4) & 1, hi = lane >> 5, r32 = lane & 31;
    const int iloc = 32 * ib + r32;
    const int t4 = tid & 255, isk = tid >> 8;
    u32x4 rq1, rq2, rv0, rv1, rs0, rs1;
#define R3_LOAD(unit) do { const int b_ = (unit) >> 9, h_ = ((unit) >> 6) & 7, n_ = (unit) & 63; const size_t row0_ = (size_t)b_ * T + n_ * 64; \
        const bf16_t* qk_ = PROJ + (row0_ + (t4 >> 2)) * LDP + (isk ? RK : RQ) + h_ * 64 + 8 * (t4 & 3); rq1 = *(const u32x4*)qk_; rq2 = *(const u32x4*)(qk_ + 32); \
        const bf16_t* v_ = PROJ + row0_ * LDP + RV + h_ * 128; rv0 = *(const u32x4*)(v_ + (size_t)(tid >> 4) * LDP + (tid & 15) * 8); rv1 = *(const u32x4*)(v_ + (size_t)(32 + (tid >> 4)) * LDP + (tid & 15) * 8); \
        const bf16_t* s_ = ST + (size_t)(unit) * 8192; rs0 = *(const u32x4*)(s_ + (tid >> 3) * 64 + (tid & 7) * 8); rs1 = *(const u32x4*)(s_ + (64 + (tid >> 3)) * 64 + (tid & 7) * 8); } while (0)
    int unit = c.bid;
    if (unit < 4096) R3_LOAD(unit);
    for (; unit < 4096; unit += c.G) {
        const int b = unit >> 9, h = (unit >> 6) & 7, n = unit & 63;
        const size_t row0 = (size_t)b * T + n * 64;
        const float l2g = L2G[h];
        __syncthreads();
        rope_write(isk ? Kimg : Qimg, rq1, rq2, t4, n * 64, isk ? 0.125f : 1.0f);
        *(LAS u32x4*)(Vimg + (tid >> 4) * RVP + (tid & 15) * 8) = rv0; *(LAS u32x4*)(Vimg + (32 + (tid >> 4)) * RVP + (tid & 15) * 8) = rv1;
        *(LAS u32x4*)(Simg + (tid >> 3) * RKP + (tid & 7) * 8) = rs0; *(LAS u32x4*)(Simg + (64 + (tid >> 3)) * RKP + (tid & 7) * 8) = rs1;
        __syncthreads();
        if (unit + c.G < 4096) R3_LOAD(unit + c.G);
        const size_t grow = row0 + iloc;
        u32x2 gw[4];
#pragma unroll
        for (int rg = 0; rg < 4; ++rg) gw[rg] = *(const u32x2*)(PROJ + grow * LDP + RG + h * 128 + 32 * eb + 8 * rg + 4 * hi);
        bf16x8 Bq[4];
#pragma unroll
        for (int ks = 0; ks < 4; ++ks) Bq[ks] = *(const LAS bf16x8*)(Qimg + iloc * RKP + 16 * ks + 8 * hi);
        bf16x8 Bx[2][2];
#pragma unroll
        for (int jb = 0; jb < 2; ++jb) {
            f32x16 a;
#pragma unroll
            for (int r = 0; r < 16; ++r) a[r] = 0.f;
#pragma unroll
            for (int ks = 0; ks < 4; ++ks) { const bf16x8 ak = *(const LAS bf16x8*)(Kimg + (32 * jb + r32) * RKP + 16 * ks + 8 * hi); a = MFMA32(ak, Bq[ks], a); }
#pragma unroll
            for (int r = 0; r < 16; ++r) { const int jl = 32 * jb + crow(r, hi); const int dd = iloc - jl; a[r] *= fast_exp2((float)(dd < 0 ? -dd : dd) * l2g); }
#pragma unroll
            for (int s2 = 0; s2 < 2; ++s2) { u32x4 w; w.x = pk2(a[8 * s2], a[8 * s2 + 1]); w.y = pk2(a[8 * s2 + 2], a[8 * s2 + 3]); w.z = pk2(a[8 * s2 + 4], a[8 * s2 + 5]); w.w = pk2(a[8 * s2 + 6], a[8 * s2 + 7]); Bx[jb][s2] = __builtin_bit_cast(bf16x8, w); }
        }
        const unsigned aV = c.ldsbase + R_OFF_V + (unsigned)(((4 * hi + q) * RVP + 32 * eb + 16 * g1 + 4 * p) * 2);
        s16x4 vl[4], vh[4];
#pragma unroll
        for (int u = 0; u < 4; ++u) { vl[u] = tr_read(aV + (unsigned)(16 * u * RVP * 2)); vh[u] = tr_read(aV + (unsigned)((16 * u + 8) * RVP * 2)); }
        asm volatile("s_waitcnt lgkmcnt(0)" ::: "memory"); SBAR();
        f32x16 oi, ox;
#pragma unroll
        for (int r = 0; r < 16; ++r) { oi[r] = 0.f; ox[r] = 0.f; }
#pragma unroll
        for (int u = 0; u < 4; ++u) oi = MFMA32(CAT8(vl[u], vh[u]), Bx[u >> 1][u & 1], oi);
#pragma unroll
        for (int ks = 0; ks < 4; ++ks) { const bf16x8 as = *(const LAS bf16x8*)(Simg + (32 * eb + r32) * RKP + 16 * ks + 8 * hi); ox = MFMA32(as, Bq[ks], ox); }
        const float qdec = fast_exp2((float)(iloc + 1) * l2g);
        float s1 = 0.f, s2 = 0.f;
#pragma unroll
        for (int r = 0; r < 16; ++r) { oi[r] = fmaf(ox[r], qdec, oi[r]); s1 += oi[r]; s2 += oi[r] * oi[r]; }
        { auto rr = __builtin_amdgcn_permlane32_swap(__float_as_uint(s1), __float_as_uint(s1), false, false); s1 = __uint_as_float(rr[0]) + __uint_as_float(rr[1]); }
        { auto rr = __builtin_amdgcn_permlane32_swap(__float_as_uint(s2), __float_as_uint(s2), false, false); s2 = __uint_as_float(rr[0]) + __uint_as_float(rr[1]); }
        if (hi == 0) stat[(ib * 4 + eb) * 32 + r32] = (f32x2){s1, s2};
        __syncthreads();
        float t1 = 0.f, t2 = 0.f;
#pragma unroll
        for (int k = 0; k < 4; ++k) { const f32x2 v = stat[(ib * 4 + k) * 32 + r32]; t1 += v.x; t2 += v.y; }
        const float mu = t1 * (1.0f / 128.0f), var = fmaxf(t2 * (1.0f / 128.0f) - mu * mu, 0.f), rstd = 1.0f / sqrtf(var + 1e-5f);
#pragma unroll
        for (int rg = 0; rg < 4; ++rg) { const int e0 = 32 * eb + 8 * rg + 4 * hi;
            const f32x4 gn = *(const f32x4*)(gain + h * 128 + e0);
            const float y0 = (oi[4 * rg] - mu) * rstd * gn.x * silu_f(bflo(gw[rg].x)), y1 = (oi[4 * rg + 1] - mu) * rstd * gn.y * silu_f(bfhi(gw[rg].x));
            const float y2 = (oi[4 * rg + 2] - mu) * rstd * gn.z * silu_f(bflo(gw[rg].y)), y3 = (oi[4 * rg + 3] - mu) * rstd * gn.w * silu_f(bfhi(gw[rg].y));
            u32x2 w; w.x = pk2(y0, y1); w.y = pk2(y2, y3);
            *(u32x2*)(YC + grow * D + 1024 + h * 128 + e0) = w; }
    }
#undef R3_LOAD
}

struct Params { const float* in[14]; float* out; unsigned char* wsp; int ph_lo, ph_hi; };
typedef const __attribute__((address_space(4))) Params* KArgP;
DI KArgP kargs() { KArgP p = (KArgP)__builtin_amdgcn_kernarg_segment_ptr(); asm volatile("" : "+s"(p)); return p; }
#define KA (kargs())
__global__ void __launch_bounds__(NTHREADS, 2) mk_fwd(Params P) {
#define ws (as_global(KA->wsp))
#define H (as_global(KA->out))
#define HB ((bf16_t*)(ws + WS_XN))
#define ACT ((bf16_t*)(ws + WS_ACT))
#define PROJ ((bf16_t*)(ws + WS_PROJ))
#define YC ((bf16_t*)(ws + WS_YC))
#define SC ((unsigned*)(ws + WS_SC))
#define BM ((unsigned long long*)(ws + WS_BM))
#define KVT ((float*)(ws + WS_KVT))
#define ST ((bf16_t*)(ws + WS_ST))
#define IKW ((bf16_t*)(ws + WS_IKW))
#define SSQ ((float*)(ws + WS_SSQ))
#define RSTD ((float*)(ws + WS_RSTD))
#define GAINS(l, k) (as_global(KA->in[1]) + (size_t)((l) * 3 + (k)) * D)
    extern __shared__ __attribute__((aligned(16))) unsigned char lds_raw[];
    Ctx c0;
    c0.lds = (LAS unsigned char*)lds_raw; c0.ldsbase = (unsigned)(uintptr_t)lds_raw;
    c0.wave = __builtin_amdgcn_readfirstlane((int)threadIdx.x >> 6);
    c0.G = gridDim.x; c0.bid = blockIdx.x; c0.gw = c0.bid * NWAVES + c0.wave; c0.NGW = c0.G * NWAVES;
    volatile LAS unsigned* misc = (volatile LAS unsigned*)(c0.lds + LDS_MISC);
    if (threadIdx.x < 16) misc[threadIdx.x] = 0u;
    __syncthreads();
    const int lo = P.ph_lo, hi = P.ph_hi;
    XcdBarrier bar; bar.bar = (unsigned*)(P.wsp + WS_CTL); bar.x = 0; bar.st = misc;
    if (hi - lo > 1) bar = xcd_barrier_post((unsigned*)(P.wsp + WS_CTL), misc);
    int pid = 0;
#define PH_BEGIN_K(k) if (pid >= lo && pid < hi) { for (int rep_ = 0; rep_ < (((k) >= 0 && ((MK_DUPMASK >> ((k) & 31)) & 1u)) ? 2 : 1); ++rep_) { if (rep_) xcd_barrier(bar); Ctx c = c0; asm volatile("" : "+s"(c.bid), "+s"(c.G), "+s"(c.gw), "+s"(c.NGW), "+s"(c.wave), "+s"(c.ldsbase));
#define PH_BEGIN PH_BEGIN_K(-2)
#define HOUT (rep_ ? (bf16_t*)(ws + WS_END) : HB)
#define SSQOUT (rep_ ? (float*)(ws + WS_END + 128 * MiB) : SSQ)
#define PH_END   } if (pid + 1 < hi) { xcd_barrier(bar); if (MK_XBAR) xcd_barrier(bar); } } ++pid;


    PH_BEGIN if (EN(0)) { phase_fold(c, as_global(KA->in[6]), as_global(KA->in[7]), as_global(KA->in[8]), (float*)(ws + WS_WP)); phase_first(c, as_global(KA->in[0]), HB, RSTD); } PH_END
    PH_BEGIN_K(1) if (EN(1)) phase_convert(c, KA, ws); PH_END

    for (int hs = 0; hs < 2 * DEPTH; ++hs) {
        const int L = hs >> 1, sub = hs & 1;
        if (hs != 0) { PH_BEGIN_K(2) if (EN(2)) phase_rstd(c, SSQ, RSTD); PH_END }
        PH_BEGIN_K(3) if (EN(3)) { pg8::Gemm g{HB, (const bf16_t*)(ws + WS_WGU) + (size_t)hs * FF2 * D, M, FF2, D}; pg8::StaticOrder S; S.init(M, FF2, c.G, c.bid);
                   pg8::EpiSwiglu E{ACT, FF, RSTD}; pg8::gemm_phase<pg8::EpiSwiglu, pg8::StaticOrder, PG8_ALIGN, PG8_SP2>(c.lds, g, S, E); } PH_END
        PH_BEGIN_K(4) if (EN(4)) { pg8::Gemm g{ACT, (const bf16_t*)(ws + WS_WDN) + (size_t)hs * D * FF, M, D, FF}; pg8::StaticOrder S; S.init(M, D, c.G, c.bid, 4, 1);
                   pg8::EpiResid E{HB, HOUT, D, SSQOUT}; pg8::gemm_phase<pg8::EpiResid, pg8::StaticOrder, PG8_ALIGN, PG8_SP2>(c.lds, g, S, E); } PH_END
        if (sub == 0) {
            const int j = L >> 1;
            PH_BEGIN_K(2) if (EN(2)) phase_rstd(c, SSQ, RSTD); PH_END
            if ((L & 1) == 0) {
                PH_BEGIN_K(5) if (EN(5)) { pg8::Gemm g{HB, (const bf16_t*)(ws + WS_WABIN) + (size_t)j * ABIN * D, M, ABIN, D}; pg8::StaticOrder S; S.init(M, ABIN, c.G, c.bid);
                           pg8::EpiStoreBf16 E{PROJ, ABIN, nullptr, -1, RSTD}; pg8::gemm_phase<pg8::EpiStoreBf16, pg8::StaticOrder, PG8_ALIGN, PG8_SP2>(c.lds, g, S, E); } PH_END
                PH_BEGIN_K(6) if (EN(6)) phase_convpool(c, PROJ, as_global(KA->in[5]) + (size_t)j * 3 * 1024, YC); PH_END
                PH_BEGIN_K(7) if (EN(7)) { pg8::Gemm g{YC, (const bf16_t*)(ws + WS_WABOUT) + (size_t)j * D * D, M, D, D}; pg8::StaticOrder S; S.init(M, D, c.G, c.bid, 4);
                           pg8::EpiResid E{HB, HOUT, D, SSQOUT}; pg8::gemm_phase<pg8::EpiResid, pg8::StaticOrder, PG8_ALIGN, PG8_SP2>(c.lds, g, S, E); } PH_END
            } else {
                PH_BEGIN_K(8) if (EN(8)) { pg8::Gemm g{HB, (const bf16_t*)(ws + WS_WCDIN) + (size_t)j * LDP * D, M, LDP, D}; pg8::StaticOrder S; S.init(M, LDP, c.G, c.bid);
                           pg8::EpiStoreBf16 E{PROJ, LDP, IKW, 28, RSTD}; pg8::gemm_phase<pg8::EpiStoreBf16, pg8::StaticOrder, PG8_ALIGN, PG8_SP2>(c.lds, g, S, E); } PH_END
                PH_BEGIN_K(9) {
                    REP2(9) for (int u = c.bid; u < 4096; u += c.G) r1_unit(c, PROJ, KVT, u);
                    REP2(10) for (int i = c.bid; i < 1024; i += c.G) { const int qd = i >> 8, v = i & 255, b = v >> 5, lw = v & 31;
                        const int tg = qd == 0 ? lw : (qd == 1 ? 63 - lw : (qd == 2 ? 64 + lw : 127 - lw));
                        indexer_wg(c, PROJ, IKW, SC, b, tg); }
                } PH_END
                PH_BEGIN_K(11) {
                    REP2(11) phase_select(c, SC, BM);
                    REP2(12) phase_scan(c, KVT, ST);
                } PH_END
                PH_BEGIN_K(13) {
                    REP2(13) for (int i = c.bid; i < 1024; i += c.G) { const int rnd = i >> 8, v = i & 255, bh = v >> 2, s = v & 3, b = bh >> 3, h = bh & 7;
                        const int qb = rnd == 0 ? s : (rnd == 1 ? 7 - s : (rnd == 2 ? 8 + s : 15 - s));
                        const size_t brow = (size_t)b * T;
                        att::attn_unit(c, PROJ + (brow + qb * 256) * LDP + CQ + h * 128, PROJ + brow * LDP + CK + h * 128, PROJ + brow * LDP + CV + h * 128,
                                       YC + (brow + qb * 256) * D + h * 128, BM + brow * 64, qb * 256, 4 * qb + 4, h, as_global(KA->in[12])); }
                    REP2(14) phase_r3(c, PROJ, ST, as_global(KA->in[10]) + (size_t)j * 1024, YC);
                } PH_END
                PH_BEGIN_K(15) if (EN(15)) { pg8::Gemm g{YC, (const bf16_t*)(ws + WS_WCDOUT) + (size_t)j * D * D, M, D, D}; pg8::StaticOrder S; S.init(M, D, c.G, c.bid, 4);
                           pg8::EpiResid E{HB, HOUT, D, SSQOUT}; pg8::gemm_phase<pg8::EpiResid, pg8::StaticOrder, PG8_ALIGN, PG8_SP2>(c.lds, g, S, E); } PH_END
            }
        }
    }
    PH_BEGIN if (EN(16)) phase_final_norm(c, HB, as_global(KA->in[13]), H); PH_END
#undef PH_BEGIN
#undef PH_BEGIN_K
#undef HOUT
#undef SSQOUT
#undef PH_END
#undef ws
#undef H
#undef HB
#undef ACT
#undef PROJ
#undef YC
#undef SC
#undef BM
#undef KVT
#undef ST
#undef IKW
#undef SSQ
#undef RSTD
#undef GAINS
}

constexpr int N_PHASES = 2 + 2 * DEPTH * 3 - 1 + 2 * (1 + 3) + 2 * (1 + 5) + 1;
extern "C" void kernel_launch(void* const* d_in, const int* in_sizes, int n_in, void* d_out, int out_size, void* d_ws, size_t ws_size, hipStream_t stream) {
    static int grid = 0;
    if (grid == 0) {
        if (n_in != 14 || out_size != M * D || ws_size < WS_END) { fprintf(stderr, "kernel_launch: unexpected shapes (n_in %d out %d ws %zu, need %zu)\n", n_in, out_size, ws_size, (size_t)WS_END); grid = -1; return; }
        int dev = 0, cus = 0, per_cu = 0;
        if (hipGetDevice(&dev) != hipSuccess || hipDeviceGetAttribute(&cus, hipDeviceAttributeMultiprocessorCount, dev) != hipSuccess) { grid = -1; return; }
        if (hipFuncSetAttribute((const void*)mk_fwd, hipFuncAttributeMaxDynamicSharedMemorySize, LDS_BYTES) != hipSuccess) { fprintf(stderr, "kernel_launch: hipFuncSetAttribute failed\n"); grid = -1; return; }
        if (hipOccupancyMaxActiveBlocksPerMultiprocessor(&per_cu, (const void*)mk_fwd, NTHREADS, LDS_BYTES) != hipSuccess || per_cu < 1) { fprintf(stderr, "kernel_launch: occupancy query says %d blocks per CU\n", per_cu); }
        (void)hipGetLastError();
        grid = cus;
    }
    if (grid < 0) return;
    (void)hipMemsetAsync((char*)d_ws + WS_CTL, 0, CTL_ZERO_BYTES, stream);
    Params p{};
    for (int i = 0; i < 14; ++i) p.in[i] = (const float*)d_in[i];
    p.out = (float*)d_out; p.wsp = (unsigned char*)d_ws;
#if MK_ONE_LAUNCH
    p.ph_lo = 0; p.ph_hi = N_PHASES;
    hipLaunchKernelGGL(mk_fwd, dim3(grid), dim3(NTHREADS), LDS_BYTES, stream, p);
#else
    for (int ph = 0; ph < N_PHASES; ++ph) { p.ph_lo = ph; p.ph_hi = ph + 1; hipLaunchKernelGGL(mk_fwd, dim3(grid), dim3(NTHREADS), LDS_BYTES, stream, p); }
#endif
    const hipError_t le = hipPeekAtLastError();
    if (le != hipSuccess) fprintf(stderr, "kernel_launch: launch failed: %s\n", hipGetErrorName(le));
}
```
